# Optimizing an MI355X kernel written in HIP

```python
import math
import jax, jax.numpy as jnp
from jax import lax
import numpy as np

D_MODEL = 1024
BATCH = 2
SEQ = 8192
DEPTH = 2

HEAD_DIM = 64
N_HEADS = D_MODEL // HEAD_DIM
N_HEADS_SB = N_HEADS // 2
N_HEADS_DIL = N_HEADS - N_HEADS_SB
D_SB = N_HEADS_SB * HEAD_DIM
D_DIL = N_HEADS_DIL * HEAD_DIM
DIL_PATTERNS = ((128, 1), (512, 4), (2048, 16))
BLOCK = 128
N_BUCKETS = 32
MAX_DISTANCE = 2048
N_EXPERTS = 16
N_GROUPS = 4
EXPERTS_PER_GROUP = N_EXPERTS // N_GROUPS
TOP_K = 2
D_FF_EXPERT = 1024
ALPHA = (2.0 * DEPTH) ** 0.25
BETA = (8.0 * DEPTH) ** -0.25
LN_EPS = 1e-5
NEG_INF = -1e30

kernel_name = "hymba_style_sb_dilated_grouped_moe_deepnorm"


def layer_norm(x, g, b):
    xf = x.astype(jnp.float32)
    mu = xf.mean(-1, keepdims=True)
    var = jnp.square(xf - mu).mean(-1, keepdims=True)
    return ((xf - mu) * lax.rsqrt(var + LN_EPS) * g.astype(jnp.float32) + b.astype(jnp.float32)).astype(x.dtype)


def head_rms_merge(o, g):
    b, h, s, dh = o.shape
    of = o.astype(jnp.float32)
    of = of * lax.rsqrt(jnp.mean(jnp.square(of), -1, keepdims=True) + 1e-6)
    of = of.transpose(0, 2, 1, 3).reshape(b, s, h * dh)
    return (of * g.astype(jnp.float32)).astype(o.dtype)


def t5_bucket(dist):
    max_exact = N_BUCKETS // 2
    d = jnp.maximum(dist, 0)
    large = max_exact + (jnp.log(jnp.maximum(d, 1).astype(jnp.float32) / max_exact)
                         / math.log(MAX_DISTANCE / max_exact) * (N_BUCKETS - max_exact)).astype(jnp.int32)
    large = jnp.minimum(large, N_BUCKETS - 1)
    return jnp.where(d < max_exact, d, large)


def stick_breaking_attention(q, k, v):
    b, h, s, dh = q.shape
    nb = s // BLOCK
    scale = dh ** -0.5
    qb = q.reshape(b, h, nb, BLOCK, dh).transpose(2, 0, 1, 3, 4)
    kpos = jnp.arange(s)

    def one_block(args):
        qblk, n = args
        z = jnp.einsum('bhqd,bhkd->bhqk', qblk, k).astype(jnp.float32) * scale
        qpos = n * BLOCK + jnp.arange(BLOCK)
        causal = kpos[None, :] < qpos[:, None]
        log_beta = jax.nn.log_sigmoid(z)
        log_1m = jnp.where(causal, jax.nn.log_sigmoid(-z), 0.0)
        between = lax.cumsum(log_1m, axis=3, reverse=True) - log_1m
        a = jnp.where(causal, jnp.exp(log_beta + between), 0.0)
        return jnp.einsum('bhqk,bhkd->bhqd', a.astype(v.dtype), v)

    out = lax.map(one_block, (qb, jnp.arange(nb)))
    return out.transpose(1, 2, 0, 3, 4).reshape(b, h, s, dh)


def dilated_branch(q, k, v, rel_bias, window, dilation):
    b, h, s, dh = q.shape
    span = window // dilation
    n_cls = s // dilation
    nb = -(-n_cls // BLOCK)
    pad = nb * BLOCK - n_cls

    def to_classes(t):
        t = t.reshape(b, h, n_cls, dilation, dh).transpose(0, 1, 3, 2, 4)
        t = jnp.pad(t, ((0, 0), (0, 0), (0, 0), (0, pad), (0, 0)))
        return t.reshape(b, h, dilation, nb, BLOCK, dh)

    def with_prev(t):
        prev = jnp.pad(t, ((0, 0), (0, 0), (0, 0), (1, 0), (0, 0), (0, 0)))[:, :, :, :nb]
        return jnp.concatenate([prev, t], axis=4)

    qc = to_classes(q)
    kk = with_prev(to_classes(k))
    vv = with_prev(to_classes(v))
    logits = jnp.einsum('bhrnqd,bhrnkd->bhrnqk', qc, kk).astype(jnp.float32) * dh ** -0.5

    qi = jnp.arange(BLOCK)[:, None]
    kj = jnp.arange(2 * BLOCK)[None, :]
    steps = qi + BLOCK - kj
    bias = rel_bias[t5_bucket(jnp.maximum(steps, 0) * dilation)].astype(jnp.float32)
    bias = bias.transpose(2, 0, 1)
    key_cls = (jnp.arange(nb)[:, None, None] - 1) * BLOCK + kj[None]
    valid = (steps >= 0) & (steps <= span) & (key_cls >= 0)
    logits = jnp.where(valid, logits + bias[None, :, None, None], NEG_INF)

    m = logits.max(-1, keepdims=True)
    p = jnp.exp(logits - m)
    denom = p.sum(-1, keepdims=True)
    o = jnp.einsum('bhrnqk,bhrnkd->bhrnqd', p.astype(vv.dtype), vv).astype(jnp.float32) / denom
    lse = (m + jnp.log(denom))[..., 0]

    def from_classes(t):
        t = t.reshape((b, h, dilation, nb * BLOCK) + t.shape[5:])[:, :, :, :n_cls]
        t = jnp.moveaxis(t, 2, 3)
        return t.reshape((b, h, s) + t.shape[4:])

    return from_classes(o), from_classes(lse)


def dilated_attention(q, k, v, rel_bias):
    outs, lses = [], []
    for window, dilation in DIL_PATTERNS:
        o, l = dilated_branch(q, k, v, rel_bias, window, dilation)
        outs.append(o)
        lses.append(l)
    w = jax.nn.softmax(jnp.stack(lses, 0), axis=0)
    return jnp.einsum('gbhs,gbhsd->bhsd', w, jnp.stack(outs, 0)).astype(q.dtype)


def token_mixer(x, w_in, g_sb, g_dil, w_out, rel_bias):
    b, s, _ = x.shape
    proj = jnp.einsum('bsd,de->bse', x, w_in)
    q_sb, k_sb, v_sb, q_dl, k_dl, v_dl = jnp.split(
        proj, [D_SB, 2 * D_SB, 3 * D_SB, 3 * D_SB + D_DIL, 3 * D_SB + 2 * D_DIL], axis=-1)
    to_heads = lambda t: t.reshape(b, s, -1, HEAD_DIM).transpose(0, 2, 1, 3)
    o_sb = stick_breaking_attention(to_heads(q_sb), to_heads(k_sb), to_heads(v_sb))
    o_dl = dilated_attention(to_heads(q_dl), to_heads(k_dl), to_heads(v_dl), rel_bias)
    y = jnp.concatenate([head_rms_merge(o_sb, g_sb), head_rms_merge(o_dl, g_dil)], axis=-1)
    return jnp.einsum('bse,ed->bsd', y, w_out)


def grouped_moe(x, w_router, b_router, w_gate, w_up, w_down):
    b, s, d = x.shape
    t = x.reshape(b * s, d)
    logits = (t @ w_router).astype(jnp.float32) + b_router.astype(jnp.float32)
    probs = jax.nn.softmax(logits, axis=-1)
    pg = probs.reshape(-1, N_GROUPS, EXPERTS_PER_GROUP)
    vals, idx = lax.top_k(pg, TOP_K)
    g_sel = jnp.argmax(vals.sum(-1), axis=-1)
    vals_sel = jnp.take_along_axis(vals, g_sel[:, None, None], axis=1)[:, 0]
    idx_sel = jnp.take_along_axis(idx, g_sel[:, None, None], axis=1)[:, 0]
    expert_ids = g_sel[:, None] * EXPERTS_PER_GROUP + idx_sel
    gates = vals_sel / vals_sel.sum(-1, keepdims=True)
    gate_dense = (jax.nn.one_hot(expert_ids, N_EXPERTS, dtype=jnp.float32) * gates[..., None]).sum(1)
    y = jnp.zeros_like(t)
    for e in range(N_EXPERTS):
        h = jax.nn.silu(t @ w_gate[e]) * (t @ w_up[e])
        y = y + gate_dense[:, e:e + 1].astype(t.dtype) * (h @ w_down[e])
    return y.reshape(b, s, d)


def setup_inputs(seed: int = 0) -> dict:
    key = jax.random.key(seed)
    ks = jax.random.split(key, 20)
    f32 = jnp.float32
    d = D_MODEL
    s_in = d ** -0.5
    nrm = lambda k, shape: jax.random.normal(k, shape, f32)
    x = nrm(ks[0], (BATCH, SEQ, d))

    def qkv_cols(k, width):
        kq, kk, kv = jax.random.split(k, 3)
        return [nrm(kq, (DEPTH, d, width)) * s_in,
                nrm(kk, (DEPTH, d, width)) * s_in,
                nrm(kv, (DEPTH, d, width)) * (s_in * BETA)]

    w_in = jnp.concatenate(qkv_cols(ks[1], D_SB) + qkv_cols(ks[2], D_DIL), axis=-1)
    g_sb = 1.0 + 0.05 * nrm(ks[3], (DEPTH, D_SB))
    g_dil = 1.0 + 0.05 * nrm(ks[4], (DEPTH, D_DIL))
    w_out = nrm(ks[5], (DEPTH, d, d)) * (s_in * BETA)
    ln1_g = 1.0 + 0.05 * nrm(ks[6], (DEPTH, d))
    ln1_b = 0.02 * nrm(ks[7], (DEPTH, d))
    ln2_g = 1.0 + 0.05 * nrm(ks[8], (DEPTH, d))
    ln2_b = 0.02 * nrm(ks[9], (DEPTH, d))
    rel_bias = 0.5 * nrm(ks[10], (N_BUCKETS, N_HEADS_DIL))
    w_router = nrm(ks[11], (d, N_EXPERTS)) * s_in
    b_router = 0.01 * nrm(ks[12], (N_EXPERTS,))
    w_gate = nrm(ks[13], (DEPTH, N_EXPERTS, d, D_FF_EXPERT)) * s_in
    w_up = nrm(ks[14], (DEPTH, N_EXPERTS, d, D_FF_EXPERT)) * (s_in * BETA)
    w_down = nrm(ks[15], (DEPTH, N_EXPERTS, D_FF_EXPERT, d)) * (D_FF_EXPERT ** -0.5 * BETA)
    return {"x": x, "w_in": w_in, "g_sb": g_sb, "g_dil": g_dil, "w_out": w_out,
            "ln1_g": ln1_g, "ln1_b": ln1_b, "ln2_g": ln2_g, "ln2_b": ln2_b,
            "rel_bias": rel_bias, "w_router": w_router, "b_router": b_router,
            "w_gate": w_gate, "w_up": w_up, "w_down": w_down}


def reference(x, w_in, g_sb, g_dil, w_out, ln1_g, ln1_b, ln2_g, ln2_b,
              rel_bias, w_router, b_router, w_gate, w_up, w_down):
    for l in range(DEPTH):
        h = token_mixer(x, w_in[l], g_sb[l], g_dil[l], w_out[l], rel_bias)
        x = layer_norm(ALPHA * x + h, ln1_g[l], ln1_b[l])
        h = grouped_moe(x, w_router, b_router, w_gate[l], w_up[l], w_down[l])
        x = layer_norm(ALPHA * x + h, ln2_g[l], ln2_b[l])
    return x
```

```cpp
#include <hip/hip_runtime.h>
#include <cstdio>
#include <cstdint>

constexpr int BATCH = 2, SEQ = 8192, DM = 1024, NTOK = BATCH * SEQ, NPROJ = 3072, NEXP = 16, DEPTH = 2, FF = 1024;
constexpr float ALPHA = 1.4142135623730951f;
constexpr float LN_EPS = 1e-5f;

struct GemmArgs {
    const float* A; int lda; const int* rowmap; int rowmap_stride; const int* cnt; const int* coff;
    const float* B; const float* B2; long bstride; int ldb; float* C; int ldc; int M; int K;
    const float* R; int ldr; float alpha; int pad;
};
template <int MODE>
__global__ void __launch_bounds__(256) gemm_f32(GemmArgs g) {
    __shared__ float As[16][68];
    __shared__ float Bs[16][64];
    __shared__ float Bs2[MODE == 2 ? 16 : 1][64];
    const int z = blockIdx.z, tid = threadIdx.x;
    const int M = g.cnt ? g.cnt[z] : g.M;
    const int r0 = blockIdx.y * 64, n0 = blockIdx.x * 64;
    if (r0 >= M) return;
    const int cbase = g.coff ? g.coff[z] : 0;
    const float* B = g.B + (long)z * g.bstride;
    const float* B2 = MODE == 2 ? g.B2 + (long)z * g.bstride : nullptr;
    const int lr = tid >> 2, lk = (tid & 3) * 4;
    int rr = r0 + lr; if (rr >= M) rr = M - 1;
    const long arow = g.rowmap ? (long)g.rowmap[(long)z * g.rowmap_stride + rr] : (long)(cbase + rr);
    const float* ap = g.A + arow * g.lda + lk;
    const int bk = tid >> 4, bn = (tid & 15) * 4;
    const int tx = tid & 15, ty = tid >> 4;
    float acc[4][4], acc2[4][4];
#pragma unroll
    for (int i = 0; i < 4; ++i)
#pragma unroll
        for (int j = 0; j < 4; ++j) { acc[i][j] = 0.f; acc2[i][j] = 0.f; }
    for (int k0 = 0; k0 < g.K; k0 += 16) {
        const float4 av = *(const float4*)(ap + k0);
        const float4 bv = *(const float4*)(B + (long)(k0 + bk) * g.ldb + n0 + bn);
        float4 bv2 = make_float4(0.f, 0.f, 0.f, 0.f);
        if (MODE == 2) bv2 = *(const float4*)(B2 + (long)(k0 + bk) * g.ldb + n0 + bn);
        __syncthreads();
        As[lk + 0][lr] = av.x; As[lk + 1][lr] = av.y; As[lk + 2][lr] = av.z; As[lk + 3][lr] = av.w;
        *(float4*)&Bs[bk][bn] = bv;
        if (MODE == 2) *(float4*)&Bs2[bk][bn] = bv2;
        __syncthreads();
#pragma unroll
        for (int k = 0; k < 16; ++k) {
            const float4 a = *(const float4*)&As[k][ty * 4];
            const float4 b = *(const float4*)&Bs[k][tx * 4];
            const float aa[4] = {a.x, a.y, a.z, a.w}, bb[4] = {b.x, b.y, b.z, b.w};
#pragma unroll
            for (int i = 0; i < 4; ++i)
#pragma unroll
                for (int j = 0; j < 4; ++j) acc[i][j] += aa[i] * bb[j];
            if (MODE == 2) {
                const float4 b2 = *(const float4*)&Bs2[k][tx * 4];
                const float bb2[4] = {b2.x, b2.y, b2.z, b2.w};
#pragma unroll
                for (int i = 0; i < 4; ++i)
#pragma unroll
                    for (int j = 0; j < 4; ++j) acc2[i][j] += aa[i] * bb2[j];
            }
        }
    }
#pragma unroll
    for (int i = 0; i < 4; ++i) {
        const int r = r0 + ty * 4 + i;
        if (r >= M) continue;
        float o[4];
#pragma unroll
        for (int j = 0; j < 4; ++j) {
            float v = acc[i][j];
            if (MODE == 2) { const float gte = v; v = gte / (1.f + expf(-gte)) * acc2[i][j]; }
            o[j] = v;
        }
        const long crow = cbase + r;
        if (MODE == 1) {
            const float4 rv = *(const float4*)(g.R + crow * g.ldr + n0 + tx * 4);
            o[0] += g.alpha * rv.x; o[1] += g.alpha * rv.y; o[2] += g.alpha * rv.z; o[3] += g.alpha * rv.w;
        }
        *(float4*)(g.C + crow * g.ldc + n0 + tx * 4) = make_float4(o[0], o[1], o[2], o[3]);
    }
}

__global__ void __launch_bounds__(64) sb_attn_naive(const float* __restrict__ proj, const float* __restrict__ gain, float* __restrict__ Y) {
    __shared__ float Ks[64][64];
    __shared__ float Vs[64][64];
    const int lane = threadIdx.x, qb = blockIdx.x, h = blockIdx.y, b = blockIdx.z;
    const int t = qb * 64 + lane;
    const float* base = proj + (long)b * SEQ * NPROJ;
    float q[64], o[64];
    {
        const float* qp = base + (long)t * NPROJ + h * 64;
#pragma unroll
        for (int d = 0; d < 64; d += 4) { const float4 v = *(const float4*)(qp + d); q[d] = v.x * 0.125f; q[d + 1] = v.y * 0.125f; q[d + 2] = v.z * 0.125f; q[d + 3] = v.w * 0.125f; }
#pragma unroll
        for (int d = 0; d < 64; ++d) o[d] = 0.f;
    }
    float R = 0.f;
    for (int kt = qb; kt >= 0; --kt) {
        __syncthreads();
#pragma unroll
        for (int it = 0; it < 16; ++it) {
            const int row = it * 4 + (lane >> 4), c4 = (lane & 15) * 4;
            const float* kp = base + (long)(kt * 64 + row) * NPROJ + 512 + h * 64 + c4;
            *(float4*)&Ks[row][c4] = *(const float4*)kp;
            *(float4*)&Vs[row][c4] = *(const float4*)(kp + 512);
        }
        __syncthreads();
        for (int j = 63; j >= 0; --j) {
            const int kj = kt * 64 + j;
            float z = 0.f;
#pragma unroll
            for (int d = 0; d < 64; d += 4) { const float4 kv = *(const float4*)&Ks[j][d]; z += q[d] * kv.x + q[d + 1] * kv.y + q[d + 2] * kv.z + q[d + 3] * kv.w; }
            const float sp = fmaxf(z, 0.f) + log1pf(expf(-fabsf(z)));
            const bool valid = kj < t;
            const float a = valid ? expf(z - sp + R) : 0.f;
            if (valid) R -= sp;
#pragma unroll
            for (int d = 0; d < 64; d += 4) { const float4 vv = *(const float4*)&Vs[j][d]; o[d] += a * vv.x; o[d + 1] += a * vv.y; o[d + 2] += a * vv.z; o[d + 3] += a * vv.w; }
        }
        if (__all(R < -110.f)) break;
    }
    float ss = 0.f;
#pragma unroll
    for (int d = 0; d < 64; ++d) ss += o[d] * o[d];
    const float rs = rsqrtf(ss * (1.f / 64.f) + 1e-6f);
    float* yp = Y + ((long)b * SEQ + t) * DM + h * 64;
#pragma unroll
    for (int d = 0; d < 64; d += 4) {
        const float4 gv = *(const float4*)(gain + h * 64 + d);
        *(float4*)(yp + d) = make_float4(o[d] * rs * gv.x, o[d + 1] * rs * gv.y, o[d + 2] * rs * gv.z, o[d + 3] * rs * gv.w);
    }
}

__device__ __forceinline__ int t5_bucket(int d) {
    if (d < 16) return d;
    return 16 + (d >= 22) + (d >= 30) + (d >= 40) + (d >= 54) + (d >= 73) + (d >= 99) + (d >= 134) + (d >= 182) + (d >= 246) + (d >= 332) + (d >= 450) + (d >= 609) + (d >= 825) + (d >= 1117) + (d >= 1513);
}
__global__ void __launch_bounds__(64) dil_attn_naive(const float* __restrict__ proj, const float* __restrict__ rel_bias, const float* __restrict__ gain, float* __restrict__ Y) {
    __shared__ float bt[32];
    const int lane = threadIdx.x, h = blockIdx.y, b = blockIdx.z;
    const int t = blockIdx.x * 64 + lane;
    if (lane < 32) bt[lane] = rel_bias[lane * 8 + h];
    __syncthreads();
    const float* base = proj + (long)b * SEQ * NPROJ;
    float q[64], o[64];
    {
        const float* qp = base + (long)t * NPROJ + 1536 + h * 64;
#pragma unroll
        for (int d = 0; d < 64; d += 4) { const float4 v = *(const float4*)(qp + d); q[d] = v.x * 0.125f; q[d + 1] = v.y * 0.125f; q[d + 2] = v.z * 0.125f; q[d + 3] = v.w * 0.125f; }
#pragma unroll
        for (int d = 0; d < 64; ++d) o[d] = 0.f;
    }
    float m = -1e30f, l = 0.f;
    for (int br = 0; br < 3; ++br) {
        const int dil = br == 0 ? 1 : (br == 1 ? 4 : 16);
        for (int st = 0; st <= 128; ++st) {
            const int j = t - st * dil;
            if (j < 0) break;
            const float* kp = base + (long)j * NPROJ + 2048 + h * 64;
            float z = 0.f;
#pragma unroll
            for (int d = 0; d < 64; d += 4) { const float4 kv = *(const float4*)(kp + d); z += q[d] * kv.x + q[d + 1] * kv.y + q[d + 2] * kv.z + q[d + 3] * kv.w; }
            z += bt[t5_bucket(st * dil)];
            const float mn = fmaxf(m, z), sc = expf(m - mn), p = expf(z - mn);
            l = l * sc + p; m = mn;
            const float* vp = kp + 512;
#pragma unroll
            for (int d = 0; d < 64; d += 4) { const float4 vv = *(const float4*)(vp + d); o[d] = o[d] * sc + p * vv.x; o[d + 1] = o[d + 1] * sc + p * vv.y; o[d + 2] = o[d + 2] * sc + p * vv.z; o[d + 3] = o[d + 3] * sc + p * vv.w; }
        }
    }
    const float il = 1.f / l;
    float ss = 0.f;
#pragma unroll
    for (int d = 0; d < 64; ++d) { o[d] *= il; ss += o[d] * o[d]; }
    const float rs = rsqrtf(ss * (1.f / 64.f) + 1e-6f);
    float* yp = Y + ((long)b * SEQ + t) * DM + 512 + h * 64;
#pragma unroll
    for (int d = 0; d < 64; d += 4) {
        const float4 gv = *(const float4*)(gain + h * 64 + d);
        *(float4*)(yp + d) = make_float4(o[d] * rs * gv.x, o[d + 1] * rs * gv.y, o[d + 2] * rs * gv.z, o[d + 3] * rs * gv.w);
    }
}

__device__ __forceinline__ float wave_sum(float v) {
#pragma unroll
    for (int o = 1; o < 64; o <<= 1) v += __shfl_xor(v, o);
    return v;
}
__global__ void __launch_bounds__(256) ln_rows(const float* __restrict__ T, const float* __restrict__ g, const float* __restrict__ bb, float* __restrict__ out) {
    const int lane = threadIdx.x & 63, row = blockIdx.x * 4 + (threadIdx.x >> 6);
    const float4* xr = (const float4*)(T + (long)row * DM) + lane;
    float4 v[4]; float s = 0.f;
#pragma unroll
    for (int j = 0; j < 4; ++j) { v[j] = xr[64 * j]; s += (v[j].x + v[j].y) + (v[j].z + v[j].w); }
    const float mean = wave_sum(s) * (1.f / DM); float s2 = 0.f;
#pragma unroll
    for (int j = 0; j < 4; ++j) { v[j].x -= mean; v[j].y -= mean; v[j].z -= mean; v[j].w -= mean; s2 += (v[j].x * v[j].x + v[j].y * v[j].y) + (v[j].z * v[j].z + v[j].w * v[j].w); }
    const float rstd = rsqrtf(wave_sum(s2) * (1.f / DM) + LN_EPS);
    float4* o4 = (float4*)(out + (long)row * DM) + lane;
#pragma unroll
    for (int j = 0; j < 4; ++j) {
        const float4 gv = ((const float4*)g)[lane + 64 * j], bv = ((const float4*)bb)[lane + 64 * j];
        o4[64 * j] = make_float4(v[j].x * rstd * gv.x + bv.x, v[j].y * rstd * gv.y + bv.y, v[j].z * rstd * gv.z + bv.z, v[j].w * rstd * gv.w + bv.w);
    }
}

struct TokInfo { int e1, e2, s1, s2; float g1, g2; int pad0, pad1; };
__global__ void __launch_bounds__(256) router(const float* __restrict__ X1, const float* __restrict__ wr, const float* __restrict__ br, int* __restrict__ cnt, int* __restrict__ perm, TokInfo* __restrict__ info) {
    const int lane = threadIdx.x & 63, tok = blockIdx.x * 4 + (threadIdx.x >> 6);
    float acc[16];
#pragma unroll
    for (int e = 0; e < 16; ++e) acc[e] = 0.f;
    const float* xr = X1 + (long)tok * DM;
    for (int i = 0; i < 16; ++i) {
        const int k = lane + 64 * i; const float xv = xr[k];
        const float4* w4 = (const float4*)(wr + (long)k * 16);
#pragma unroll
        for (int e4 = 0; e4 < 4; ++e4) { const float4 w = w4[e4]; acc[e4 * 4] += xv * w.x; acc[e4 * 4 + 1] += xv * w.y; acc[e4 * 4 + 2] += xv * w.z; acc[e4 * 4 + 3] += xv * w.w; }
    }
    float mx = -1e30f;
#pragma unroll
    for (int e = 0; e < 16; ++e) { acc[e] = wave_sum(acc[e]) + br[e]; mx = fmaxf(mx, acc[e]); }
    float p[16];
#pragma unroll
    for (int e = 0; e < 16; ++e) p[e] = expf(acc[e] - mx);
    float best = -1.f; int be1 = 0, be2 = 0; float bv1 = 0.f, bv2 = 0.f;
#pragma unroll
    for (int gI = 0; gI < 4; ++gI) {
        float v1 = -1.f, v2 = -1.f; int i1 = 0, i2 = 0;
#pragma unroll
        for (int j = 0; j < 4; ++j) {
            const float pv = p[gI * 4 + j];
            if (pv > v1) { v2 = v1; i2 = i1; v1 = pv; i1 = j; }
            else if (pv > v2) { v2 = pv; i2 = j; }
        }
        const float sm = v1 + v2;
        if (sm > best) { best = sm; be1 = gI * 4 + i1; be2 = gI * 4 + i2; bv1 = v1; bv2 = v2; }
    }
    if (lane == 0) {
        const int s1 = atomicAdd(&cnt[be1], 1), s2 = atomicAdd(&cnt[be2], 1);
        perm[be1 * NTOK + s1] = tok; perm[be2 * NTOK + s2] = tok;
        TokInfo ti; ti.e1 = be1; ti.e2 = be2; ti.s1 = s1; ti.s2 = s2; ti.g1 = bv1 / (bv1 + bv2); ti.g2 = bv2 / (bv1 + bv2); ti.pad0 = 0; ti.pad1 = 0;
        info[tok] = ti;
    }
}
__global__ void scan16(const int* __restrict__ cnt, int* __restrict__ off) {
    if (threadIdx.x == 0) { int s = 0; for (int e = 0; e < 16; ++e) { off[e] = s; s += cnt[e]; } }
}
__global__ void __launch_bounds__(256) combine_ln(const float* __restrict__ X1, const float* __restrict__ YP, const TokInfo* __restrict__ info, const int* __restrict__ off,
                                                  const float* __restrict__ g, const float* __restrict__ bb, float* __restrict__ out) {
    const int lane = threadIdx.x & 63, row = blockIdx.x * 4 + (threadIdx.x >> 6);
    const TokInfo ti = info[row];
    const float4* xr = (const float4*)(X1 + (long)row * DM) + lane;
    const float4* y1 = (const float4*)(YP + (long)(off[ti.e1] + ti.s1) * DM) + lane;
    const float4* y2 = (const float4*)(YP + (long)(off[ti.e2] + ti.s2) * DM) + lane;
    float4 v[4]; float s = 0.f;
#pragma unroll
    for (int j = 0; j < 4; ++j) {
        const float4 x = xr[64 * j], a = y1[64 * j], c = y2[64 * j];
        v[j].x = ALPHA * x.x + (ti.g1 * a.x + ti.g2 * c.x); v[j].y = ALPHA * x.y + (ti.g1 * a.y + ti.g2 * c.y);
        v[j].z = ALPHA * x.z + (ti.g1 * a.z + ti.g2 * c.z); v[j].w = ALPHA * x.w + (ti.g1 * a.w + ti.g2 * c.w);
        s += (v[j].x + v[j].y) + (v[j].z + v[j].w);
    }
    const float mean = wave_sum(s) * (1.f / DM); float s2 = 0.f;
#pragma unroll
    for (int j = 0; j < 4; ++j) { v[j].x -= mean; v[j].y -= mean; v[j].z -= mean; v[j].w -= mean; s2 += (v[j].x * v[j].x + v[j].y * v[j].y) + (v[j].z * v[j].z + v[j].w * v[j].w); }
    const float rstd = rsqrtf(wave_sum(s2) * (1.f / DM) + LN_EPS);
    float4* o4 = (float4*)(out + (long)row * DM) + lane;
#pragma unroll
    for (int j = 0; j < 4; ++j) {
        const float4 gv = ((const float4*)g)[lane + 64 * j], bv = ((const float4*)bb)[lane + 64 * j];
        o4[64 * j] = make_float4(v[j].x * rstd * gv.x + bv.x, v[j].y * rstd * gv.y + bv.y, v[j].z * rstd * gv.z + bv.z, v[j].w * rstd * gv.w + bv.w);
    }
}

extern "C" void kernel_launch(void* const* d_in, const int* in_sizes, int n_in, void* d_out, int out_size, void* d_ws, size_t ws_size, hipStream_t stream) {
    const float* x = (const float*)d_in[0];
    const float* w_in = (const float*)d_in[1];
    const float* g_sb = (const float*)d_in[2];
    const float* g_dil = (const float*)d_in[3];
    const float* w_out = (const float*)d_in[4];
    const float* ln1_g = (const float*)d_in[5];
    const float* ln1_b = (const float*)d_in[6];
    const float* ln2_g = (const float*)d_in[7];
    const float* ln2_b = (const float*)d_in[8];
    const float* rel_bias = (const float*)d_in[9];
    const float* w_router = (const float*)d_in[10];
    const float* b_router = (const float*)d_in[11];
    const float* w_gate = (const float*)d_in[12];
    const float* w_up = (const float*)d_in[13];
    const float* w_down = (const float*)d_in[14];
    constexpr size_t MiB = 1u << 20;
    if (ws_size < 452 * MiB) { fprintf(stderr, "ws too small: %zu\n", ws_size); return; }
    char* ws = (char*)d_ws;
    int* cnt = (int*)ws;
    int* perm = (int*)(ws + 1 * MiB);
    TokInfo* info = (TokInfo*)(ws + 2 * MiB);
    float* PROJ = (float*)(ws + 4 * MiB);
    float* H = PROJ;
    float* Y = (float*)(ws + 196 * MiB);
    float* T = (float*)(ws + 260 * MiB);
    float* YP = Y;
    float* X1 = (float*)(ws + 324 * MiB);
    float* XC = (float*)(ws + 388 * MiB);
    hipMemsetAsync(ws, 0, 4096, stream);
    const float* xin = x;
    for (int l = 0; l < DEPTH; ++l) {
        int* cntl = cnt + l * 16; int* offl = cnt + 64 + l * 16;
        { GemmArgs g{}; g.A = xin; g.lda = DM; g.B = w_in + (size_t)l * DM * NPROJ; g.ldb = NPROJ; g.C = PROJ; g.ldc = NPROJ; g.M = NTOK; g.K = DM;
          hipLaunchKernelGGL(gemm_f32<0>, dim3(NPROJ / 64, NTOK / 64, 1), dim3(256), 0, stream, g); }
        hipLaunchKernelGGL(sb_attn_naive, dim3(SEQ / 64, 8, BATCH), dim3(64), 0, stream, PROJ, g_sb + l * 512, Y);
        hipLaunchKernelGGL(dil_attn_naive, dim3(SEQ / 64, 8, BATCH), dim3(64), 0, stream, PROJ, rel_bias, g_dil + l * 512, Y);
        { GemmArgs g{}; g.A = Y; g.lda = DM; g.B = w_out + (size_t)l * DM * DM; g.ldb = DM; g.C = T; g.ldc = DM; g.M = NTOK; g.K = DM; g.R = xin; g.ldr = DM; g.alpha = ALPHA;
          hipLaunchKernelGGL(gemm_f32<1>, dim3(DM / 64, NTOK / 64, 1), dim3(256), 0, stream, g); }
        hipLaunchKernelGGL(ln_rows, dim3(NTOK / 4), dim3(256), 0, stream, T, ln1_g + l * DM, ln1_b + l * DM, X1);
        hipLaunchKernelGGL(router, dim3(NTOK / 4), dim3(256), 0, stream, X1, w_router, b_router, cntl, perm, info);
        hipLaunchKernelGGL(scan16, dim3(1), dim3(64), 0, stream, cntl, offl);
        { GemmArgs g{}; g.A = X1; g.lda = DM; g.rowmap = perm; g.rowmap_stride = NTOK; g.cnt = cntl; g.coff = offl;
          g.B = w_gate + (size_t)l * NEXP * DM * FF; g.B2 = w_up + (size_t)l * NEXP * DM * FF; g.bstride = (long)DM * FF; g.ldb = FF; g.C = H; g.ldc = FF; g.M = NTOK; g.K = DM;
          hipLaunchKernelGGL(gemm_f32<2>, dim3(FF / 64, NTOK / 64, NEXP), dim3(256), 0, stream, g); }
        { GemmArgs g{}; g.A = H; g.lda = FF; g.cnt = cntl; g.coff = offl;
          g.B = w_down + (size_t)l * NEXP * FF * DM; g.bstride = (long)FF * DM; g.ldb = DM; g.C = YP; g.ldc = DM; g.M = NTOK; g.K = FF;
          hipLaunchKernelGGL(gemm_f32<0>, dim3(DM / 64, NTOK / 64, NEXP), dim3(256), 0, stream, g); }
        float* xo = (l == DEPTH - 1) ? (float*)d_out : XC;
        hipLaunchKernelGGL(combine_ln, dim3(NTOK / 4), dim3(256), 0, stream, X1, YP, info, offl, ln2_g + l * DM, ln2_b + l * DM, xo);
        xin = xo;
    }
}
```

```cpp
#include <hip/hip_runtime.h>
#include <cstdio>
#include <cstdint>

constexpr int BATCH = 2, SEQ = 8192, DM = 1024, NTOK = BATCH * SEQ, NPROJ = 3072, NEXP = 16, DEPTH = 2, FF = 1024;
constexpr float ALPHA = 1.4142135623730951f;
constexpr float LN_EPS = 1e-5f;
constexpr float LOG2E = 1.4426950408889634f, LN2 = 0.6931471805599453f;
constexpr float QSCALE = 0.125f * LOG2E;

#ifndef FAST_GEMM
#define FAST_GEMM 1
#endif
#ifndef FAST_ATT
#define FAST_ATT 1
#endif
#ifndef FAST_THIN
#define FAST_THIN 1
#endif

typedef unsigned short bf16_t;
#define LAS __attribute__((address_space(3)))
#define GAS __attribute__((address_space(1)))
typedef float f32x4 __attribute__((ext_vector_type(4)));
typedef float f32x2 __attribute__((ext_vector_type(2)));
typedef float f32x16 __attribute__((ext_vector_type(16)));
typedef short bf16x8 __attribute__((ext_vector_type(8)));
typedef unsigned u32x4 __attribute__((ext_vector_type(4)));
typedef unsigned u32x2 __attribute__((ext_vector_type(2)));

__device__ __forceinline__ float bf2f(bf16_t v) { return __uint_as_float((unsigned)v << 16); }
__device__ __forceinline__ unsigned f2bf(float f) { unsigned u = __float_as_uint(f); return (u + 0x7fffu + ((u >> 16) & 1u)) >> 16; }
__device__ __forceinline__ unsigned pk2(float lo, float hi) { return f2bf(lo) | (f2bf(hi) << 16); }
__device__ __forceinline__ unsigned cvt_pk_bf16(float lo, float hi) { unsigned r; asm volatile("v_cvt_pk_bf16_f32 %0, %1, %2" : "=v"(r) : "v"(lo), "v"(hi)); return r; }

constexpr size_t MiB = 1u << 20;
constexpr size_t WS_CTL = 0, CTL_ZERO_BYTES = 65536;
constexpr size_t WS_PERM = 1 * MiB, WS_INFO = 2 * MiB;
constexpr size_t WS_WIN = 4 * MiB, WS_WOUT = 10 * MiB, WS_WGU = 12 * MiB, WS_WD = 76 * MiB;
constexpr size_t WS_XB = 108 * MiB, WS_XC = 140 * MiB, WS_PROJ = 204 * MiB, WS_H = 204 * MiB;
constexpr size_t WS_Y = 300 * MiB, WS_T = 332 * MiB, WS_YP = 300 * MiB, WS_X1 = 396 * MiB, WS_X1B = 460 * MiB, WS_END = 492 * MiB;
constexpr int CW_TMO = 0, CW_CNT = 64  , CW_OFF = 128  , CW_BAR = 1024;

struct TokInfo { int e1, e2, s1, s2; float g1, g2; int pad0, pad1; };

namespace pg8 {
constexpr int BM = 256, BK = 64, HALF = 128, HTB = HALF * BK * 2, STAGE_BYTES = 8 * HTB;
__host__ __device__ __forceinline__ int lds_byte(int r, int c) { const int st = (r >> 4) * 2 + (c >> 5), rr = r & 15, cc = c & 31, ob = rr * 64 + cc * 2; return st * 1024 + (ob ^ (((ob >> 9) & 1) << 5)); }
__host__ __device__ __forceinline__ void stage_rc(int b, int& R, int& C) { const int st = b / 1024, sb = b % 1024, swz = sb ^ (((sb >> 9) & 1) << 5); R = (st >> 1) * 16 + swz / 64; C = (st & 1) * 32 + (swz % 64) / 2; }
__host__ __device__ __forceinline__ int perm32(int rho) { const int n = rho >> 4, i = rho & 15; return 8 * (i >> 2) + 4 * n + (i & 3); }

struct Unit { int pm, pn, e; };

struct EpiProj {
    static constexpr bool PERM = true;
    bf16_t* O;
    __device__ __forceinline__ void operator()(const f32x4 (&acc)[2][2][4][2], const Unit& u, int wr, int wc, int fr, int fq) const {
        const int row0 = u.pm * BM + wr * 64 + fr; const int col0 = u.pn * BM + wc * 32 + 8 * fq;
        const float sc = (u.pn < 2 || u.pn == 6 || u.pn == 7) ? QSCALE : 1.f;
#pragma unroll
        for (int ai = 0; ai < 2; ++ai)
#pragma unroll
            for (int m = 0; m < 4; ++m) { bf16_t* rowp = O + (size_t)(row0 + ai * HALF + m * 16) * NPROJ + col0;
#pragma unroll
                for (int bj = 0; bj < 2; ++bj) { const f32x4 v0 = acc[ai][bj][m][0] * sc, v1 = acc[ai][bj][m][1] * sc;
                    u32x4 w; w.x = cvt_pk_bf16(v0[0], v0[1]); w.y = cvt_pk_bf16(v0[2], v0[3]); w.z = cvt_pk_bf16(v1[0], v1[1]); w.w = cvt_pk_bf16(v1[2], v1[3]);
                    *(u32x4*)(rowp + bj * HALF) = w; } }
    }
};
struct EpiPlain {
    static constexpr bool PERM = true;
    bf16_t* O; int ldc;
    __device__ __forceinline__ void operator()(const f32x4 (&acc)[2][2][4][2], const Unit& u, int wr, int wc, int fr, int fq) const {
        const int row0 = u.pm * BM + wr * 64 + fr; const int col0 = u.pn * BM + wc * 32 + 8 * fq;
#pragma unroll
        for (int ai = 0; ai < 2; ++ai)
#pragma unroll
            for (int m = 0; m < 4; ++m) { bf16_t* rowp = O + (size_t)(row0 + ai * HALF + m * 16) * ldc + col0;
#pragma unroll
                for (int bj = 0; bj < 2; ++bj) { const f32x4 v0 = acc[ai][bj][m][0], v1 = acc[ai][bj][m][1];
                    u32x4 w; w.x = cvt_pk_bf16(v0[0], v0[1]); w.y = cvt_pk_bf16(v0[2], v0[3]); w.z = cvt_pk_bf16(v1[0], v1[1]); w.w = cvt_pk_bf16(v1[2], v1[3]);
                    *(u32x4*)(rowp + bj * HALF) = w; } }
    }
};
struct EpiRes {
    static constexpr bool PERM = false;
    const float* X; float* T;
    __device__ __forceinline__ void operator()(const f32x4 (&acc)[2][2][4][2], const Unit& u, int wr, int wc, int fr, int fq) const {
        const int col0 = u.pn * BM + wc * 32 + 4 * fq;
#pragma unroll
        for (int ai = 0; ai < 2; ++ai)
#pragma unroll
            for (int m = 0; m < 4; ++m) { const size_t off = (size_t)(u.pm * BM + ai * HALF + wr * 64 + m * 16 + fr) * DM + col0;
#pragma unroll
                for (int bj = 0; bj < 2; ++bj)
#pragma unroll
                    for (int n = 0; n < 2; ++n) { const f32x4 xv = *(const f32x4*)(X + off + bj * HALF + n * 16); *(f32x4*)(T + off + bj * HALF + n * 16) = xv * ALPHA + acc[ai][bj][m][n]; } }
    }
};
struct EpiSwiGLU {
    static constexpr bool PERM = true;
    bf16_t* O;
    __device__ __forceinline__ void operator()(const f32x4 (&acc)[2][2][4][2], const Unit& u, int wr, int wc, int fr, int fq) const {
        const int row0 = u.pm * BM + wr * 64 + fr; const int col0 = u.pn * HALF + wc * 32 + 8 * fq;
#pragma unroll
        for (int ai = 0; ai < 2; ++ai)
#pragma unroll
            for (int m = 0; m < 4; ++m) { bf16_t* rowp = O + (size_t)(row0 + ai * HALF + m * 16) * FF + col0;
                float h[8];
#pragma unroll
                for (int n = 0; n < 2; ++n)
#pragma unroll
                    for (int j = 0; j < 4; ++j) { const float g = acc[ai][0][m][n][j], up = acc[ai][1][m][n][j];
                        h[n * 4 + j] = g * __builtin_amdgcn_rcpf(1.f + __builtin_amdgcn_exp2f(-g * LOG2E)) * up; }
                u32x4 w; w.x = cvt_pk_bf16(h[0], h[1]); w.y = cvt_pk_bf16(h[2], h[3]); w.z = cvt_pk_bf16(h[4], h[5]); w.w = cvt_pk_bf16(h[6], h[7]);
                *(u32x4*)rowp = w; }
    }
};

template <class Epi, class Sched, bool GATHER, bool ALIGN_EPI>
__device__ __forceinline__ void gemm_phase(LAS unsigned char* lds, const int K, const Sched& S, const Epi& E) {
    int tid_l = threadIdx.x; asm volatile("" : "+v"(tid_l));
    const int tid = tid_l, wid = __builtin_amdgcn_readfirstlane(tid >> 6), lane = tid & 63, wr = wid >> 2, wc = wid & 3, fr = lane & 15, fq = lane >> 4;
    const int nt = K / BK;
    unsigned voffA[2], voffB[2]; int gR[2];
#pragma unroll
    for (int i = 0; i < 2; ++i) { int R, C; stage_rc(tid * 16 + i * 8192, R, C); const int Rb = Epi::PERM ? ((R & ~31) + perm32(R & 31)) : R;
        voffA[i] = GATHER ? (unsigned)(C * 2) : (unsigned)(R * K + C) * 2u; voffB[i] = (unsigned)(Rb * K + C) * 2u; gR[i] = R; }
    const size_t kstep = (size_t)(BK * 2);
    const size_t hstep = (size_t)HALF * K * 2;
    const unsigned ldsw = (unsigned)wid * 1024u;
    const int aoff = lds_byte(wr * 64 + fr, fq * 8), boff = lds_byte(wc * 32 + fr, fq * 8);
    unsigned goff[2][2];
#define PG8_SA(b, h) (((b) * 2 + (h)) * HTB)
#define PG8_SB(b, h) ((4 + (b) * 2 + (h)) * HTB)
#define PG8_GLDS(gp, bufoff, i) __builtin_amdgcn_global_load_lds((const unsigned*)(gp), (LAS unsigned*)(lds + (bufoff) + ldsw + (i) * 8192), 16, 0, 0)
#define PG8_STAGE_B(bufoff, gbase) do { _Pragma("unroll") for (int _i = 0; _i < 2; ++_i) PG8_GLDS((const char*)(gbase) + voffB[_i], bufoff, _i); } while (0)
#define PG8_STAGE_A(bufoff, gbase, h) do { _Pragma("unroll") for (int _i = 0; _i < 2; ++_i) { \
        if constexpr (GATHER) PG8_GLDS((const char*)(gbase) + goff[h][_i], bufoff, _i); else PG8_GLDS((const char*)(gbase) + (size_t)(h) * hstep + voffA[_i], bufoff, _i); } } while (0)
#define PG8_LDA(dst, b, h) do { _Pragma("unroll") for (int m = 0; m < 4; ++m) _Pragma("unroll") for (int k = 0; k < 2; ++k) dst[m][k] = *(const LAS bf16x8*)(lds + PG8_SA(b, h) + aoff + m * 2048 + k * 1024); } while (0)
#define PG8_LDB(dst, b, h) do { _Pragma("unroll") for (int n = 0; n < 2; ++n) _Pragma("unroll") for (int k = 0; k < 2; ++k) dst[n][k] = *(const LAS bf16x8*)(lds + PG8_SB(b, h) + boff + n * 2048 + k * 1024); } while (0)
#define PG8_MMA(ai, bj, At, Bt) do { __builtin_amdgcn_s_setprio(1); _Pragma("unroll") for (int m = 0; m < 4; ++m) _Pragma("unroll") for (int n = 0; n < 2; ++n) _Pragma("unroll") for (int k = 0; k < 2; ++k) \
        acc[ai][bj][m][n] = __builtin_amdgcn_mfma_f32_16x16x32_bf16(Bt[n][k], At[m][k], acc[ai][bj][m][n], 0, 0, 0); __builtin_amdgcn_s_setprio(0); } while (0)
#define PG8_WAIT_V(n) asm volatile("s_waitcnt vmcnt(" #n ")" ::: "memory")
#define PG8_WAIT_L(n) asm volatile("s_waitcnt lgkmcnt(" #n ")" ::: "memory")
#define PG8_BAR __builtin_amdgcn_s_barrier()
#define PG8_SCHED __builtin_amdgcn_sched_barrier(0)
#define PG8_GOFF(uidx) do { if constexpr (GATHER) { _Pragma("unroll") for (int _h = 0; _h < 2; ++_h) _Pragma("unroll") for (int _i = 0; _i < 2; ++_i) goff[_h][_i] = S.grow(uidx, _h * HALF + gR[_i]) + voffA[_i]; } } while (0)
    Unit cur, nxt; int ui = 0;
    if (!S.next(0, cur)) return;
    f32x4 acc[2][2][4][2];
#pragma unroll
    for (int a = 0; a < 2; ++a)
#pragma unroll
        for (int b = 0; b < 2; ++b)
#pragma unroll
            for (int m = 0; m < 4; ++m)
#pragma unroll
                for (int n = 0; n < 2; ++n) acc[a][b][m][n] = (f32x4){0.f, 0.f, 0.f, 0.f};
    bf16x8 At[4][2], B0[2][2], B1[2][2];
    const char* cA = S.a_base(cur); const char* cB = S.b_base(cur);
    PG8_GOFF(0);
    PG8_STAGE_B(PG8_SB(0, 0), cB); PG8_STAGE_B(PG8_SB(0, 1), cB + hstep); PG8_STAGE_A(PG8_SA(0, 0), cA, 0); PG8_STAGE_A(PG8_SA(0, 1), cA, 1);
    if (wr == 1) PG8_BAR;
    PG8_WAIT_V(2); PG8_BAR;
    PG8_STAGE_B(PG8_SB(1, 0), cB + kstep); PG8_STAGE_A(PG8_SA(1, 0), cA + kstep, 0); PG8_STAGE_B(PG8_SB(1, 1), cB + hstep + kstep);
    PG8_WAIT_V(6); PG8_BAR;
    for (;;) {
        const bool has_next = S.next(ui + 1, nxt);
        const char* nA = has_next ? S.a_base(nxt) : cA; const char* nB = has_next ? S.b_base(nxt) : cB;
        for (int t = 0; t < nt; t += 2) {
            const bool last = (t == nt - 2);
            const char* a1 = cA + (size_t)(t + 1) * kstep;
            const char* a2 = last ? nA : cA + (size_t)(t + 2) * kstep; const char* b2 = last ? nB : cB + (size_t)(t + 2) * kstep;
            const char* a3 = a2 + kstep; const char* b3 = b2 + kstep;
            PG8_LDB(B0, 0, 0); PG8_LDB(B1, 0, 1); PG8_SCHED; PG8_LDA(At, 0, 0); PG8_STAGE_A(PG8_SA(1, 1), a1, 1);
            if (GATHER && last && has_next) { PG8_GOFF(ui + 1); }
            PG8_WAIT_V(8); PG8_WAIT_L(0); PG8_BAR; PG8_MMA(0, 0, At, B0); PG8_MMA(0, 1, At, B1); PG8_BAR; PG8_SCHED;
            PG8_LDA(At, 0, 1); PG8_STAGE_B(PG8_SB(0, 0), b2); PG8_STAGE_B(PG8_SB(0, 1), b2 + hstep); PG8_STAGE_A(PG8_SA(0, 0), a2, 0);
            PG8_WAIT_V(8); PG8_WAIT_L(0); PG8_BAR; PG8_MMA(1, 0, At, B0); PG8_MMA(1, 1, At, B1); PG8_BAR; PG8_SCHED;
            PG8_LDB(B0, 1, 0); PG8_LDB(B1, 1, 1); PG8_SCHED; PG8_LDA(At, 1, 0); PG8_STAGE_A(PG8_SA(0, 1), a2, 1);
            PG8_WAIT_V(8); PG8_WAIT_L(0); PG8_BAR; PG8_MMA(0, 0, At, B0); PG8_MMA(0, 1, At, B1); PG8_BAR; PG8_SCHED;
            PG8_LDA(At, 1, 1); PG8_STAGE_B(PG8_SB(1, 0), b3); PG8_STAGE_B(PG8_SB(1, 1), b3 + hstep); PG8_STAGE_A(PG8_SA(1, 0), a3, 0);
            PG8_WAIT_V(8); PG8_WAIT_L(0); PG8_BAR; PG8_MMA(1, 0, At, B0); PG8_MMA(1, 1, At, B1); PG8_BAR; PG8_SCHED;
        }
        if constexpr (ALIGN_EPI) { if (wr == 0) PG8_BAR; }
        E(acc, cur, wr, wc, fr, fq);
        if (!has_next) break;
#pragma unroll
        for (int a = 0; a < 2; ++a)
#pragma unroll
            for (int b = 0; b < 2; ++b)
#pragma unroll
                for (int m = 0; m < 4; ++m)
#pragma unroll
                    for (int n = 0; n < 2; ++n) acc[a][b][m][n] = (f32x4){0.f, 0.f, 0.f, 0.f};
        cur = nxt; cA = nA; cB = nB; ++ui;
        if constexpr (ALIGN_EPI) { if (wr == 1) PG8_BAR; }
    }
    PG8_WAIT_V(0);
    if constexpr (!ALIGN_EPI) { if (wr == 0) PG8_BAR; }
    PG8_BAR;
#undef PG8_SA
#undef PG8_SB
#undef PG8_GLDS
#undef PG8_STAGE_A
#undef PG8_STAGE_B
#undef PG8_LDA
#undef PG8_LDB
#undef PG8_MMA
#undef PG8_WAIT_V
#undef PG8_WAIT_L
#undef PG8_BAR
#undef PG8_SCHED
#undef PG8_GOFF
}

struct DenseSched {
    int nM, nN, nwg, G, c; const char* A; const char* Bt; size_t tstep;
    __device__ __forceinline__ void init(int M, int N, int K, int G_, int c_, const void* A_, const void* Bt_) { nM = M / BM; nN = N / BM; nwg = nM * nN; G = G_; c = c_; A = (const char*)A_; Bt = (const char*)Bt_; tstep = (size_t)BM * K * 2; }
    __device__ __forceinline__ bool next(int i, Unit& u) const {
        const long L = (long)i * G + c; if (L >= nwg) return false;
        int wgid = (int)L; { const int q = nwg / 8, r = nwg % 8, xcd = wgid % 8, off = wgid / 8; wgid = (xcd < r ? xcd * (q + 1) : r * (q + 1) + (xcd - r) * q) + off; }
        const int nig = 8 * nN, gid = wgid / nig, fm = gid * 8, gsz = (nM - fm) < 8 ? (nM - fm) : 8;
        u.pm = fm + ((wgid % nig) % gsz); u.pn = (wgid % nig) / gsz; u.e = 0; return true;
    }
    __device__ __forceinline__ const char* a_base(const Unit& u) const { return A + (size_t)u.pm * tstep; }
    __device__ __forceinline__ const char* b_base(const Unit& u) const { return Bt + (size_t)u.pn * tstep; }
    __device__ __forceinline__ unsigned grow(int, int) const { return 0u; }
};
struct MoeSched {
    const LAS int* ul; const LAS unsigned* tab; const char* A; const char* Bt; size_t tstepA, tstepB, estrideB;
    __device__ __forceinline__ bool next(int i, Unit& u) const {
        if (i >= 8) return false;
        const int ok = __builtin_amdgcn_readfirstlane(ul[i * 4 + 3]); if (!ok) return false;
        u.pm = __builtin_amdgcn_readfirstlane(ul[i * 4]); u.pn = __builtin_amdgcn_readfirstlane(ul[i * 4 + 1]); u.e = __builtin_amdgcn_readfirstlane(ul[i * 4 + 2]); return true;
    }
    __device__ __forceinline__ const char* a_base(const Unit& u) const { return A + (size_t)u.pm * tstepA; }
    __device__ __forceinline__ const char* b_base(const Unit& u) const { return Bt + (size_t)u.e * estrideB + (size_t)u.pn * tstepB; }
    __device__ __forceinline__ unsigned grow(int ui, int r) const { return tab[ui * 256 + r]; }
};
}


__device__ __forceinline__ int t5_bucket(int d) {
    if (d < 16) return d;
    return 16 + (d >= 22) + (d >= 30) + (d >= 40) + (d >= 54) + (d >= 73) + (d >= 99) + (d >= 134) + (d >= 182) + (d >= 246) + (d >= 332) + (d >= 450) + (d >= 609) + (d >= 825) + (d >= 1117) + (d >= 1513);
}
namespace att {
typedef __bf16 bf16x2_t __attribute__((ext_vector_type(2)));
typedef short s16x4 __attribute__((ext_vector_type(4)));
__device__ __forceinline__ unsigned cvtpk(float lo, float hi) { f32x2 v = {lo, hi}; bf16x2_t b = __builtin_convertvector(v, bf16x2_t); return __builtin_bit_cast(unsigned, b); }
__device__ __forceinline__ int crow(int r, int hi) { return (r & 3) + 8 * (r >> 2) + 4 * hi; }
__device__ __forceinline__ s16x4 vtr(LAS const unsigned char* p) { return __builtin_bit_cast(s16x4, __builtin_amdgcn_ds_read_tr16_b64_v4i16((LAS s16x4*)p)); }
constexpr int WL_BYTES = 16384;
constexpr int WL_V = 8192;
__device__ __forceinline__ void glds16(const void* gsrc, unsigned lds_dst) { unsigned keep;
    asm volatile("s_mov_b32 %0, m0\n\ts_mov_b32 m0, %2\n\ts_nop 0\n\tglobal_load_lds_dwordx4 %1, off\n\ts_mov_b32 m0, %0" : "=&s"(keep) : "v"(gsrc), "s"(lds_dst) : "memory"); }
__device__ __forceinline__ void dma_k(unsigned wl_addr, const bf16_t* kb, int t_first, int tstride, int lane) {
    const int r32 = lane & 31, hi = lane >> 5;
#pragma unroll
    for (int blk = 0; blk < 2; ++blk) { int tok = t_first + (r32 + 32 * blk) * tstride; tok = tok < 0 ? 0 : tok; const bf16_t* p = kb + (size_t)tok * NPROJ + 8 * hi;
#pragma unroll
        for (int d0 = 0; d0 < 4; ++d0) glds16(p + 16 * d0, (unsigned)__builtin_amdgcn_readfirstlane(wl_addr + (blk * 4 + d0) * 1024)); }
}
__device__ __forceinline__ void dma_v(unsigned wl_addr, const bf16_t* vb, int t_first, int tstride, int lane) {
#pragma unroll
    for (int kg = 0; kg < 4; ++kg) { int tok = t_first + (16 * kg + (lane >> 2)) * tstride; tok = tok < 0 ? 0 : tok; const bf16_t* p = vb + (size_t)tok * NPROJ + (lane & 3) * 8;
        glds16(p, (unsigned)__builtin_amdgcn_readfirstlane(wl_addr + WL_V + kg * 1024)); glds16(p + 32, (unsigned)__builtin_amdgcn_readfirstlane(wl_addr + WL_V + (4 + kg) * 1024)); }
}
__device__ __forceinline__ void read_k(bf16x8 (&kf)[8], LAS const unsigned char* wl, int lane) {
#pragma unroll
    for (int i = 0; i < 8; ++i) kf[i] = *(LAS const bf16x8*)(wl + i * 1024 + lane * 16);
    asm volatile("s_waitcnt lgkmcnt(0)" ::: "memory");
}
#define ATT_WAIT_V(n) asm volatile("s_waitcnt vmcnt(" #n ")" ::: "memory")
__device__ __forceinline__ void qk_tile(f32x16& p0, f32x16& p1, const bf16x8 (&kf)[8], const bf16x8 (&qf)[4]) {
    p0 = (f32x16){}; p1 = (f32x16){};
#pragma unroll
    for (int d0 = 0; d0 < 4; ++d0) { p0 = __builtin_amdgcn_mfma_f32_32x32x16_bf16(kf[d0], qf[d0], p0, 0, 0, 0); p1 = __builtin_amdgcn_mfma_f32_32x32x16_bf16(kf[4 + d0], qf[d0], p1, 0, 0, 0); }
}
__device__ __forceinline__ void pv_tile(f32x16 (&o)[2], const f32x16& p0, const f32x16& p1, LAS const unsigned char* wl, int lane) {
    const int hi = lane >> 5;
    u32x4 pw[4];
    pw[0] = (u32x4){cvtpk(p0[0], p0[1]), cvtpk(p0[2], p0[3]), cvtpk(p0[4], p0[5]), cvtpk(p0[6], p0[7])};
    pw[1] = (u32x4){cvtpk(p0[8], p0[9]), cvtpk(p0[10], p0[11]), cvtpk(p0[12], p0[13]), cvtpk(p0[14], p0[15])};
    pw[2] = (u32x4){cvtpk(p1[0], p1[1]), cvtpk(p1[2], p1[3]), cvtpk(p1[4], p1[5]), cvtpk(p1[6], p1[7])};
    pw[3] = (u32x4){cvtpk(p1[8], p1[9]), cvtpk(p1[10], p1[11]), cvtpk(p1[12], p1[13]), cvtpk(p1[14], p1[15])};
    LAS const unsigned char* vp = wl + WL_V + ((lane >> 4) & 1) * 32 + (lane & 3) * 8 + (4 * hi + ((lane & 15) >> 2)) * 64;
#pragma unroll
    for (int d0 = 0; d0 < 2; ++d0)
#pragma unroll
        for (int ks = 0; ks < 4; ++ks) {
            const s16x4 lo = vtr(vp + d0 * 4096 + ks * 1024), hh = vtr(vp + d0 * 4096 + ks * 1024 + 512);
            const bf16x8 vf = (bf16x8){lo[0], lo[1], lo[2], lo[3], hh[0], hh[1], hh[2], hh[3]};
            o[d0] = __builtin_amdgcn_mfma_f32_32x32x16_bf16(__builtin_bit_cast(bf16x8, pw[ks]), vf, o[d0], 0, 0, 0);
        }
}
__device__ __forceinline__ void epilogue(const f32x16 (&o)[2], float lq_val, LAS unsigned char* wl, LAS float* lq, const float* gain64, bf16_t* Yb, int ycol, int tok0, int tokstride, int lane) {
    const int r32 = lane & 31, hi = lane >> 5;
    LAS float* stg = (LAS float*)wl;
    ATT_WAIT_V(0);
#pragma unroll
    for (int d0 = 0; d0 < 2; ++d0)
#pragma unroll
        for (int r = 0; r < 16; ++r) stg[crow(r, hi) * 68 + 32 * d0 + r32] = o[d0][r];
    if (hi == 0) lq[r32] = lq_val;
    asm volatile("s_waitcnt lgkmcnt(0)" ::: "memory");
    const int row = lane >> 1, half = lane & 1;
    const float sc = lq[row];
    f32x4 v[8]; float ss = 0.f;
#pragma unroll
    for (int j = 0; j < 8; ++j) { v[j] = *(LAS const f32x4*)(wl + row * 272 + half * 128 + j * 16) * sc; ss += (v[j].x * v[j].x + v[j].y * v[j].y) + (v[j].z * v[j].z + v[j].w * v[j].w); }
    ss += __shfl_xor(ss, 1);
    const float rs = rsqrtf(ss * (1.f / 64.f) + 1e-6f);
    bf16_t* yp = Yb + (size_t)(tok0 + row * tokstride) * DM + ycol + half * 32;
    const float* gp = gain64 + half * 32;
#pragma unroll
    for (int j = 0; j < 4; ++j) {
        const f32x4 g0 = *(const f32x4*)(gp + 8 * j), g1 = *(const f32x4*)(gp + 8 * j + 4); const f32x4 a = v[2 * j] * rs * g0, c = v[2 * j + 1] * rs * g1;
        u32x4 w; w.x = cvtpk(a.x, a.y); w.y = cvtpk(a.z, a.w); w.z = cvtpk(c.x, c.y); w.w = cvtpk(c.z, c.w);
        *(u32x4*)(yp + 8 * j) = w;
    }
    asm volatile("s_waitcnt lgkmcnt(0)" ::: "memory");
}

__device__ __forceinline__ void sb_half(f32x16& p, float (&L)[16], int cbase, int lo_c, unsigned span) {
#pragma unroll
    for (int r = 0; r < 16; ++r) {
        const int c = cbase + (r & 3) + 8 * (r >> 2);
        const float z = ((unsigned)(c - lo_c) < span) ? p[r] : -1e30f;
        const float ez = __builtin_amdgcn_exp2f(-__builtin_fabsf(z)); const float lg = __builtin_amdgcn_logf(1.f + ez); const float sp = __builtin_fmaxf(z, 0.f) + lg;
        L[r] = -sp; p[r] = z - sp;
    }
}
__device__ __forceinline__ void sb_elem(f32x16& p0, f32x16& p1, float& R2, int hi, int lim, int lo) {
    float L0[16], L1[16];
    const int lo_c = lo - 4 * hi; const unsigned span = (unsigned)(lim - lo);
    sb_half(p0, L0, 0, lo_c, span); sb_half(p1, L1, 32, lo_c, span);
    float gs[8], ps[8], og[8];
#pragma unroll
    for (int k = 0; k < 4; ++k) { gs[k] = (L0[4 * k] + L0[4 * k + 1]) + (L0[4 * k + 2] + L0[4 * k + 3]); gs[4 + k] = (L1[4 * k] + L1[4 * k + 1]) + (L1[4 * k + 2] + L1[4 * k + 3]); }
#pragma unroll
    for (int k = 0; k < 8; ++k) { auto rr = __builtin_amdgcn_permlane32_swap(__float_as_uint(gs[k]), __float_as_uint(gs[k]), false, false);
        const float a = __uint_as_float(rr[0]), b = __uint_as_float(rr[1]); ps[k] = a + b; og[k] = hi ? 0.f : b; }
    float T[8]; float run = R2;
#pragma unroll
    for (int k = 7; k >= 0; --k) { T[k] = run + og[k]; run += ps[k]; }
    R2 = run;
#pragma unroll
    for (int k = 0; k < 4; ++k) {
        { float b = T[k]; p0[4 * k + 3] = __builtin_amdgcn_exp2f(p0[4 * k + 3] + b); b += L0[4 * k + 3]; p0[4 * k + 2] = __builtin_amdgcn_exp2f(p0[4 * k + 2] + b); b += L0[4 * k + 2];
          p0[4 * k + 1] = __builtin_amdgcn_exp2f(p0[4 * k + 1] + b); b += L0[4 * k + 1]; p0[4 * k] = __builtin_amdgcn_exp2f(p0[4 * k] + b); }
        { float b = T[4 + k]; p1[4 * k + 3] = __builtin_amdgcn_exp2f(p1[4 * k + 3] + b); b += L1[4 * k + 3]; p1[4 * k + 2] = __builtin_amdgcn_exp2f(p1[4 * k + 2] + b); b += L1[4 * k + 2];
          p1[4 * k + 1] = __builtin_amdgcn_exp2f(p1[4 * k + 1] + b); b += L1[4 * k + 1]; p1[4 * k] = __builtin_amdgcn_exp2f(p1[4 * k] + b); }
    }
}
__device__ __forceinline__ void sb_unit(const bf16_t* pb, int h, int q0, LAS unsigned char* wl, LAS float* wsc, const float* gain, bf16_t* Yb, int lane) {
    asm volatile("" : "+v"(lane));
    const int r32 = lane & 31, hi = lane >> 5;
    const unsigned wl_addr = (unsigned)(size_t)wl;
    bf16x8 qf[4];
    { const bf16_t* qp = pb + (size_t)(q0 + r32) * NPROJ + h * 64 + 8 * hi;
#pragma unroll
      for (int d0 = 0; d0 < 4; ++d0) qf[d0] = *(const bf16x8*)(qp + 16 * d0); }
    const bf16_t* kb = pb + 512 + h * 64; const bf16_t* vb = pb + 1024 + h * 64;
    const int nt = (q0 + 31) / 64 + 1;
    f32x16 o[2]; o[0] = (f32x16){}; o[1] = (f32x16){};
    float R2 = 0.f;
    asm volatile("s_waitcnt vmcnt(0)" ::: "memory");
    dma_k(wl_addr, kb, q0 - 32, 1, lane); dma_v(wl_addr, vb, q0 - 32, 1, lane);
    for (int j = 0; j < nt; ++j) {
        const int t_first = q0 - 32 - 64 * j; const bool more = (j + 1 < nt);
        ATT_WAIT_V(8);
        bf16x8 kf[8]; read_k(kf, wl, lane);
        if (more) dma_k(wl_addr, kb, t_first - 64, 1, lane);
        f32x16 p0, p1;
        qk_tile(p0, p1, kf, qf);
        sb_elem(p0, p1, R2, hi, (q0 + r32) - t_first, t_first < 0 ? -t_first : 0);
        if (more) ATT_WAIT_V(8); else ATT_WAIT_V(0);
        pv_tile(o, p0, p1, wl, lane);
        asm volatile("s_waitcnt lgkmcnt(0)" ::: "memory");
        if (__all(R2 < -150.f)) break;
        if (more) dma_v(wl_addr, vb, t_first - 64, 1, lane);
    }
    epilogue(o, 1.f, wl, wsc, gain + h * 64, Yb, h * 64, q0, 1, lane);
}
__device__ __forceinline__ void dil_elem(f32x16& p0, f32x16& p1, float& m, float& l, f32x16 (&o)[2], int sbl, int lo_c, int sh, LAS const float* tab, LAS float* wsf, int r32, int hi) {
    float tmax = -3e38f;
#pragma unroll
    for (int blk = 0; blk < 2; ++blk)
#pragma unroll
        for (int r = 0; r < 16; ++r) {
            const int c = 32 * blk + (r & 3) + 8 * (r >> 2); const int steps = sbl - c; const bool v = ((unsigned)steps <= 128u) && (c >= lo_c);
            const float bias = tab[v ? (steps << sh) : 0]; const float z = blk ? p1[r] : p0[r]; const float s = v ? z + bias : -3e38f;
            if (blk) p1[r] = s; else p0[r] = s; tmax = __builtin_fmaxf(tmax, s);
        }
    { auto rr = __builtin_amdgcn_permlane32_swap(__float_as_uint(tmax), __float_as_uint(tmax), false, false); tmax = __builtin_fmaxf(__uint_as_float(rr[0]), __uint_as_float(rr[1])); }
    const float mnew = __builtin_fmaxf(m, tmax);
    if (__any(mnew > m)) {
        const float f = __builtin_amdgcn_exp2f(m - mnew); l *= f;
        if (hi == 0) wsf[r32] = f;
        asm volatile("s_waitcnt lgkmcnt(0)" ::: "memory");
#pragma unroll
        for (int r = 0; r < 16; ++r) { const float fr = wsf[crow(r, hi)]; o[0][r] *= fr; o[1][r] *= fr; }
        asm volatile("s_waitcnt lgkmcnt(0)" ::: "memory");
    }
    m = mnew;
    float acc = 0.f;
#pragma unroll
    for (int r = 0; r < 16; ++r) { p0[r] = __builtin_amdgcn_exp2f(p0[r] - m); p1[r] = __builtin_amdgcn_exp2f(p1[r] - m); acc += p0[r] + p1[r]; }
    l += acc;
}
__device__ __forceinline__ void dil_params(int ti, int t0, int& t_first, int& tstride, int& sh, int& pk  , int& kc0, int& qs) {
    int j;
    if (ti < 10) { sh = 0; j = ti; } else if (ti < 14) { sh = 2; j = ti - 10; } else { sh = 4; j = ti - 14; }
    tstride = 1 << sh; qs = 16 >> sh;
    const int r = t0 & (tstride - 1), P0 = t0 >> sh;
    kc0 = P0 + qs * 31 - 63 - 64 * j; pk = P0 - kc0; t_first = r + tstride * kc0;
}
__device__ __forceinline__ void dil_unit(const bf16_t* pb, int h, int t0, LAS unsigned char* wl, LAS float* wsc, LAS const float* tab, const float* gain, bf16_t* Yb, int lane) {
    asm volatile("" : "+v"(lane));
    const int r32 = lane & 31, hi = lane >> 5;
    const unsigned wl_addr = (unsigned)(size_t)wl;
    bf16x8 qf[4];
    { const bf16_t* qp = pb + (size_t)(t0 + 16 * r32) * NPROJ + 1536 + h * 64 + 8 * hi;
#pragma unroll
      for (int d0 = 0; d0 < 4; ++d0) qf[d0] = *(const bf16x8*)(qp + 16 * d0); }
    const bf16_t* kb = pb + 2048 + h * 64; const bf16_t* vb = pb + 2560 + h * 64;
    f32x16 o[2]; o[0] = (f32x16){}; o[1] = (f32x16){};
    float m = -1e30f, l = 0.f;
    int t_first, tstride, sh, pk, kc0, qs;
    dil_params(0, t0, t_first, tstride, sh, pk, kc0, qs);
    asm volatile("s_waitcnt vmcnt(0)" ::: "memory");
    dma_k(wl_addr, kb, t_first, tstride, lane); dma_v(wl_addr, vb, t_first, tstride, lane);
    for (int ti = 0; ti < 17; ++ti) {
        const int c_sh = sh, c_pk = pk, c_kc0 = kc0, c_qs = qs; const bool more = (ti + 1 < 17);
        ATT_WAIT_V(8);
        bf16x8 kf[8]; read_k(kf, wl, lane);
        if (more) { dil_params(ti + 1, t0, t_first, tstride, sh, pk, kc0, qs); dma_k(wl_addr, kb, t_first, tstride, lane); }
        f32x16 p0, p1;
        qk_tile(p0, p1, kf, qf);
        dil_elem(p0, p1, m, l, o, c_pk + c_qs * r32 - 4 * hi, -c_kc0 - 4 * hi, c_sh, tab, wsc + 32, r32, hi);
        if (more) ATT_WAIT_V(8); else ATT_WAIT_V(0);
        pv_tile(o, p0, p1, wl, lane);
        asm volatile("s_waitcnt lgkmcnt(0)" ::: "memory");
        if (more) dma_v(wl_addr, vb, t_first, tstride, lane);
    }
    { auto rr = __builtin_amdgcn_permlane32_swap(__float_as_uint(l), __float_as_uint(l), false, false); l = __uint_as_float(rr[0]) + __uint_as_float(rr[1]); }
    epilogue(o, 1.f / l, wl, wsc, gain + h * 64, Yb, 512 + h * 64, t0, 16, lane);
}
}

#define XB_TMO      128
#define XB_XCNT(j)  (256  + 64 * (j))
#define XB_XSUB(j)  (1280 + 64 * (j))
#define XB_XGEN(j)  (2304 + 64 * (j))
#define XB_TOP      3328
#define XB_TOPGEN   3392
#define XCD_BAR_WORDS 3456
#define XB_SPIN_CAP (1u << 18)
__device__ __forceinline__ unsigned xb_ld(unsigned* p)              { return __hip_atomic_load(p, __ATOMIC_RELAXED, __HIP_MEMORY_SCOPE_AGENT); }
__device__ __forceinline__ unsigned xb_add(unsigned* p, unsigned v) { return __hip_atomic_fetch_add(p, v, __ATOMIC_RELAXED, __HIP_MEMORY_SCOPE_AGENT); }
__device__ __forceinline__ unsigned xb_xcc_id() { return (unsigned)__builtin_amdgcn_s_getreg((3 << 11) | 20) & 0xFu; }
#define XB_SPIN(cond, bar) do { unsigned _sp = 0; while (cond) { __builtin_amdgcn_s_sleep(1); \
    if ((++_sp & 255u) == 0u) { if (xb_ld(&(bar)[XB_TMO])) break; if (_sp > XB_SPIN_CAP) { atomicAdd(&(bar)[XB_TMO], 1u); break; } } } } while (0)
struct XcdBarrier { unsigned* bar; unsigned x; volatile LAS unsigned* st; };
__device__ __forceinline__ XcdBarrier xcd_barrier_post(unsigned* bar, volatile LAS unsigned* st) {
    XcdBarrier b; b.bar = bar; b.x = xb_xcc_id(); b.st = st;
    if (threadIdx.x == 0) (void)xb_add(&bar[XB_XCNT(b.x)], 1u);
    return b;
}
__device__ __forceinline__ void xcd_barrier_complete(unsigned* bar, unsigned x, unsigned& nloc, unsigned& nx) {
    const unsigned G = gridDim.x * gridDim.y * gridDim.z;
    unsigned sum, cnt, mine, sp = 0u;
    for (;;) {
        sum = 0u; cnt = 0u; mine = 0u;
#pragma unroll
        for (unsigned j = 0; j < 16; ++j) { const unsigned c = xb_ld(&bar[XB_XCNT(j)]); sum += c; cnt += (c > 0u) ? 1u : 0u; mine = (j == x) ? c : mine; }
        if (sum == G) break;
        __builtin_amdgcn_s_sleep(1);
        if ((++sp & 255u) == 0u) { if (xb_ld(&bar[XB_TMO])) break; if (sp > XB_SPIN_CAP) { atomicAdd(&bar[XB_TMO], 1u); break; } }
    }
    nloc = mine > 0u ? mine : 1u; nx = cnt > 0u ? cnt : 1u;
}
__device__ __forceinline__ void xcd_barrier(const XcdBarrier& b) {
    asm volatile("s_waitcnt vmcnt(0)" ::: "memory");
    __syncthreads();
    if (threadIdx.x == 0) {
        unsigned* bar = b.bar;
        __builtin_amdgcn_s_waitcnt(0);
        unsigned nloc = b.st[0], nx = b.st[1];
        if (nloc == 0u) { xcd_barrier_complete(bar, b.x, nloc, nx); b.st[0] = nloc; b.st[1] = nx; }
        const unsigned old = xb_add(&bar[XB_XSUB(b.x)], 1u);
        const unsigned gen = old / nloc;
        if (old + 1u == (gen + 1u) * nloc) {
            __builtin_amdgcn_fence(__ATOMIC_RELEASE, "agent");
            asm volatile("s_waitcnt vmcnt(0)" ::: "memory");
            const unsigned og = xb_add(&bar[XB_TOP], 1u);
            const unsigned tg = og / nx;
            if (og + 1u == (tg + 1u) * nx) xb_add(&bar[XB_TOPGEN], 1u);
            else XB_SPIN(xb_ld(&bar[XB_TOPGEN]) == tg, bar);
            __builtin_amdgcn_fence(__ATOMIC_ACQUIRE, "agent");
            xb_add(&bar[XB_XGEN(b.x)], 1u);
            asm volatile("s_waitcnt vmcnt(0)" ::: "memory");
        } else {
            XB_SPIN(xb_ld(&bar[XB_XGEN(b.x)]) == gen, bar);
            __builtin_amdgcn_fence(__ATOMIC_ACQUIRE, "agent");
            asm volatile("s_waitcnt vmcnt(0)" ::: "memory");
        }
    }
    __syncthreads();
}

constexpr int NWAVES = 8;
constexpr int RING_BYTES = 131072;
constexpr int TAB_OFF = RING_BYTES;
constexpr int PB_OFF = TAB_OFF + 8192;
constexpr int MISC_OFF = PB_OFF + 512;
constexpr int WSC_OFF = MISC_OFF + 256;
constexpr int LDS_BYTES = 147456;
static_assert(WSC_OFF + 2048 <= LDS_BYTES, "LDS map");
constexpr int PH_PER_LAYER = 8, N_PHASES = DEPTH * PH_PER_LAYER;
enum { PH_W = 0, PH_QKV = 1, PH_ATT = 2, PH_OUT = 3, PH_LNR = 4, PH_MOE1 = 5, PH_MOE2 = 6, PH_COMB = 7 };

struct Args { const float* in[15]; float* out; unsigned char* ws; int ph_lo, ph_hi; };

__device__ __forceinline__ float wave_sum(float v) {
#pragma unroll
    for (int o = 1; o < 64; o <<= 1) v += __shfl_xor(v, o);
    return v;
}
__device__ __forceinline__ void transpose_item(const float* W, int K, int N, bf16_t* WT, int row_off, LAS float* scr, int kb, int nb, int lane) {
    const int k0 = 64 * kb, n0 = 32 * nb;
#pragma unroll 8
    for (int i = 0; i < 32; ++i) { const int kk = 2 * i + (lane >> 5); scr[kk * 33 + (lane & 31)] = W[(size_t)(k0 + kk) * N + n0 + (lane & 31)]; }
    asm volatile("s_waitcnt lgkmcnt(0)" ::: "memory");
    const int c = lane & 7;
#pragma unroll
    for (int j = 0; j < 4; ++j) { const int n = (lane >> 3) + 8 * j; const LAS float* s = scr + (8 * c) * 33 + n;
        u32x4 o; o.x = pk2(s[0 * 33], s[1 * 33]); o.y = pk2(s[2 * 33], s[3 * 33]); o.z = pk2(s[4 * 33], s[5 * 33]); o.w = pk2(s[6 * 33], s[7 * 33]);
        *(u32x4*)(WT + (size_t)(row_off + n0 + n) * K + k0 + 8 * c) = o; }
    asm volatile("s_waitcnt lgkmcnt(0)" ::: "memory");
}

__global__ void __launch_bounds__(NWAVES * 64, 2) mk(Args args) {
    extern __shared__ __attribute__((aligned(16))) unsigned char lds_raw[];
    LAS unsigned char* lds = (LAS unsigned char*)lds_raw;
    volatile LAS unsigned* MISC = (volatile LAS unsigned*)(lds + MISC_OFF);
    const int tid = threadIdx.x, lane = tid & 63, wave = __builtin_amdgcn_readfirstlane(tid >> 6);
    const int G = gridDim.x; const int bx = blockIdx.x; const int vcu = (G % 8 == 0) ? (bx % 8) * (G / 8) + bx / 8 : bx;
    unsigned char* ws = args.ws;
    unsigned* ctl = (unsigned*)(ws + WS_CTL);
    for (int u = tid; u < 32; u += NWAVES * 64) MISC[u] = 0u;
    __syncthreads();
    const bool multi = (args.ph_hi - args.ph_lo) > 1;
    XcdBarrier bar; bar.bar = ctl + CW_BAR; bar.x = 0; bar.st = nullptr;
    if (multi) bar = xcd_barrier_post(ctl + CW_BAR, MISC + 8);

    const float* x_in = args.in[0]; const float* w_in = args.in[1]; const float* w_out = args.in[4];
    const float* w_gate = args.in[12]; const float* w_up = args.in[13]; const float* w_down = args.in[14];
    bf16_t* Win_t = (bf16_t*)(ws + WS_WIN); bf16_t* Wout_t = (bf16_t*)(ws + WS_WOUT); bf16_t* Wgu_t = (bf16_t*)(ws + WS_WGU); bf16_t* Wd_t = (bf16_t*)(ws + WS_WD);
    bf16_t* XB = (bf16_t*)(ws + WS_XB); float* XC = (float*)(ws + WS_XC); bf16_t* PROJ = (bf16_t*)(ws + WS_PROJ); bf16_t* HB = (bf16_t*)(ws + WS_H);
    bf16_t* Y = (bf16_t*)(ws + WS_Y); float* T = (float*)(ws + WS_T); bf16_t* YP = (bf16_t*)(ws + WS_YP); bf16_t* X1B = (bf16_t*)(ws + WS_X1B);
    const int* perm = (const int*)(ws + WS_PERM);

#define IN(k) (args.ph_lo <= (k) && (k) < args.ph_hi)
#define SEAM(k) do { if (IN(k) && IN((k) + 1)) xcd_barrier(bar); } while (0)
    for (int l = 0; l < DEPTH; ++l) {
        const int pbase = l * PH_PER_LAYER;
        const float* xres = (l == 0) ? x_in : XC;
        if (IN(pbase + PH_W)) {
            int tl = threadIdx.x; asm volatile("" : "+v"(tl)); const int lane = tl & 63, wave = __builtin_amdgcn_readfirstlane(tl >> 6);
            LAS float* scr = (LAS float*)(lds + wave * 16384);
            const int gw = vcu * NWAVES + wave, NGW = G * NWAVES;
            constexpr int I_IN = 16 * 96, I_SQ = 16 * 32, NITEMS = I_IN + I_SQ + 48 * I_SQ;
            for (int it = gw; it < NITEMS; it += NGW) {
                int r = it;
                if (r < I_IN) { transpose_item(w_in + (size_t)l * DM * NPROJ, DM, NPROJ, Win_t, 0, scr, r / 96, r % 96, lane); continue; } r -= I_IN;
                if (r < I_SQ) { transpose_item(w_out + (size_t)l * DM * DM, DM, DM, Wout_t, 0, scr, r / 32, r % 32, lane); continue; } r -= I_SQ;
                const int mtx = r / I_SQ, e = mtx / 3, kind = mtx % 3, rr = r % I_SQ, kb = rr / 32, nb = rr % 32;
                const size_t eoff = ((size_t)l * NEXP + e) * DM * FF;
                if (kind == 2) transpose_item(w_down + eoff, FF, DM, Wd_t + (size_t)e * DM * FF, 0, scr, kb, nb, lane);
                else transpose_item((kind == 0 ? w_gate : w_up) + eoff, DM, FF, Wgu_t + (size_t)e * 2 * FF * DM, (nb >> 2) * 128 + kind * 128, scr, kb, nb, lane);
            }
            if (l == 0) for (int m = gw; m < NTOK; m += NGW) {
                const f32x4* xr = (const f32x4*)(x_in + (size_t)m * DM) + lane; unsigned long long* o8 = (unsigned long long*)(XB + (size_t)m * DM) + lane;
#pragma unroll
                for (int j = 0; j < 4; ++j) { const f32x4 v = xr[64 * j]; o8[64 * j] = (unsigned long long)pk2(v.x, v.y) | ((unsigned long long)pk2(v.z, v.w) << 32); }
            }
            __syncthreads();
        }
        SEAM(pbase + PH_W);
        if (IN(pbase + PH_QKV)) {
            pg8::DenseSched S; S.init(NTOK, NPROJ, DM, G, bx, XB, Win_t);
            pg8::EpiProj E{PROJ};
            pg8::gemm_phase<pg8::EpiProj, pg8::DenseSched, false, true>(lds, DM, S, E);
        }
        SEAM(pbase + PH_QKV);
        if (IN(pbase + PH_ATT)) {
            int tl = threadIdx.x; asm volatile("" : "+v"(tl)); const int lane = tl & 63, wave = __builtin_amdgcn_readfirstlane(tl >> 6);
            LAS unsigned char* wl = lds + wave * att::WL_BYTES;
            LAS float* tab = (LAS float*)(lds + TAB_OFF);
            LAS float* wsc = (LAS float*)(lds + WSC_OFF + wave * 256);
            const float* g_sb = args.in[2] + l * 512; const float* g_dil = args.in[3] + l * 512; const float* rel_bias = args.in[9];
            for (int wu = vcu; wu < 256; wu += G) {
                const int b = wu >> 7, h = (wu >> 4) & 7, blk = wu & 15;
                const bf16_t* pb = PROJ + (size_t)b * SEQ * NPROJ; bf16_t* Yb = Y + (size_t)b * SEQ * DM;
                __syncthreads();
                for (int d = tl; d <= 2048; d += NWAVES * 64) tab[d] = rel_bias[t5_bucket(d) * 8 + h] * LOG2E;
                __syncthreads();
                for (int rd = 0; rd < 2; ++rd) att::sb_unit(pb, h, blk * 512 + (rd * 8 + wave) * 32, wl, wsc, g_sb, Yb, lane);
                for (int rd = 0; rd < 2; ++rd) att::dil_unit(pb, h, blk * 512 + rd * 8 + wave, wl, wsc, tab, g_dil, Yb, lane);
            }
            __syncthreads();
        }
        SEAM(pbase + PH_ATT);
        if (IN(pbase + PH_OUT)) {
            pg8::DenseSched S; S.init(NTOK, DM, DM, G, bx, Y, Wout_t);
            pg8::EpiRes E{xres, T};
            pg8::gemm_phase<pg8::EpiRes, pg8::DenseSched, false, false>(lds, DM, S, E);
        }
        SEAM(pbase + PH_OUT);
        if (IN(pbase + PH_LNR)) {
            int tl = threadIdx.x; asm volatile("" : "+v"(tl)); const int lane = tl & 63, wave = __builtin_amdgcn_readfirstlane(tl >> 6);
            LAS float* wrt = (LAS float*)lds;
            LAS int* re = (LAS int*)(lds + 65536);
            LAS float* rg = (LAS float*)(lds + 65536 + 512);
            LAS int* sbase = (LAS int*)(lds + 65536 + 1024);
            const float* w_router = args.in[10]; const float* b_router = args.in[11];
            const float* lg = args.in[5] + l * DM; const float* lb = args.in[6] + l * DM;
            float* X1 = (float*)(ws + WS_X1); int* cnt = (int*)(ctl + CW_CNT + l * 16); int* permw = (int*)(ws + WS_PERM); TokInfo* info = (TokInfo*)(ws + WS_INFO);
            __syncthreads();
            for (int i = tl; i < 16 * DM; i += NWAVES * 64) wrt[(i & 15) * DM + (i >> 4)] = w_router[i];
            __syncthreads();
            for (int wu = vcu; wu < NTOK / 64; wu += G) {
                for (int i = 0; i < 8; ++i) {
                    const int lt = wave * 8 + i, tok = wu * 64 + lt;
                    const f32x4* xr = (const f32x4*)(T + (size_t)tok * DM) + lane;
                    f32x4 v[4]; float s = 0.f;
#pragma unroll
                    for (int j = 0; j < 4; ++j) { v[j] = xr[64 * j]; s += (v[j].x + v[j].y) + (v[j].z + v[j].w); }
                    const float mean = wave_sum(s) * (1.f / DM); float s2 = 0.f;
#pragma unroll
                    for (int j = 0; j < 4; ++j) { v[j] = v[j] - mean; s2 += (v[j].x * v[j].x + v[j].y * v[j].y) + (v[j].z * v[j].z + v[j].w * v[j].w); }
                    const float rstd = rsqrtf(wave_sum(s2) * (1.f / DM) + LN_EPS);
                    f32x4* o4 = (f32x4*)(X1 + (size_t)tok * DM) + lane; unsigned long long* o8 = (unsigned long long*)(X1B + (size_t)tok * DM) + lane;
#pragma unroll
                    for (int j = 0; j < 4; ++j) { const f32x4 gv = ((const f32x4*)lg)[lane + 64 * j], bv = ((const f32x4*)lb)[lane + 64 * j];
                        v[j] = v[j] * rstd * gv + bv; o4[64 * j] = v[j]; o8[64 * j] = (unsigned long long)pk2(v[j].x, v[j].y) | ((unsigned long long)pk2(v[j].z, v[j].w) << 32); }
                    float acc[16];
#pragma unroll
                    for (int e = 0; e < 16; ++e) { float a = 0.f;
#pragma unroll
                        for (int j = 0; j < 4; ++j) { const f32x4 w = *(const LAS f32x4*)(wrt + e * DM + 256 * j + 4 * lane); a += (v[j].x * w.x + v[j].y * w.y) + (v[j].z * w.z + v[j].w * w.w); }
                        acc[e] = a; }
                    { const bool up = (lane & 32) != 0;
#pragma unroll
                      for (int k = 0; k < 8; ++k) { const float snd = up ? acc[k] : acc[k + 8]; const float kp = up ? acc[k + 8] : acc[k]; acc[k] = kp + __shfl_xor(snd, 32); } }
                    { const bool up = (lane & 16) != 0;
#pragma unroll
                      for (int k = 0; k < 4; ++k) { const float snd = up ? acc[k] : acc[k + 4]; const float kp = up ? acc[k + 4] : acc[k]; acc[k] = kp + __shfl_xor(snd, 16); } }
                    { const bool up = (lane & 8) != 0;
#pragma unroll
                      for (int k = 0; k < 2; ++k) { const float snd = up ? acc[k] : acc[k + 2]; const float kp = up ? acc[k + 2] : acc[k]; acc[k] = kp + __shfl_xor(snd, 8); } }
                    { const bool up = (lane & 4) != 0; const float snd = up ? acc[0] : acc[1]; const float kp = up ? acc[1] : acc[0]; acc[0] = kp + __shfl_xor(snd, 4); }
                    float tot = acc[0]; tot += __shfl_xor(tot, 2); tot += __shfl_xor(tot, 1);
                    float lgt[16]; float mx = -1e30f;
#pragma unroll
                    for (int e = 0; e < 16; ++e) { const int src = ((e >> 3) & 1) * 32 + ((e >> 2) & 1) * 16 + ((e >> 1) & 1) * 8 + (e & 1) * 4;
                        lgt[e] = __uint_as_float(__builtin_amdgcn_readlane(__float_as_uint(tot), src)) + b_router[e]; mx = fmaxf(mx, lgt[e]); }
                    float best = -1.f; int be1 = 0, be2 = 0; float bv1 = 0.f, bv2 = 0.f;
#pragma unroll
                    for (int gI = 0; gI < 4; ++gI) {
                        float v1 = -1.f, v2 = -1.f; int i1 = 0, i2 = 0;
#pragma unroll
                        for (int j = 0; j < 4; ++j) { const float pv = expf(lgt[gI * 4 + j] - mx);
                            if (pv > v1) { v2 = v1; i2 = i1; v1 = pv; i1 = j; } else if (pv > v2) { v2 = pv; i2 = j; } }
                        const float sm = v1 + v2;
                        if (sm > best) { best = sm; be1 = gI * 4 + i1; be2 = gI * 4 + i2; bv1 = v1; bv2 = v2; }
                    }
                    if (lane == 0) { re[lt * 2] = be1; re[lt * 2 + 1] = be2; rg[lt * 2] = bv1 / (bv1 + bv2); rg[lt * 2 + 1] = bv2 / (bv1 + bv2); }
                }
                __syncthreads();
                if (wave == 0) {
                    if (lane < 16) { int n = 0; for (int q = 0; q < 128; ++q) n += (re[q] == lane) ? 1 : 0; sbase[lane] = n ? (int)__hip_atomic_fetch_add(cnt + lane, n, __ATOMIC_RELAXED, __HIP_MEMORY_SCOPE_AGENT) : 0; }
                    asm volatile("s_waitcnt vmcnt(0) lgkmcnt(0)" ::: "memory");
                    const int e1 = re[lane * 2], e2 = re[lane * 2 + 1]; int r1 = 0, r2 = 0;
                    for (int q = 0; q < lane; ++q) { const int a = re[q * 2], b2 = re[q * 2 + 1]; r1 += (a == e1) + (b2 == e1); r2 += (a == e2) + (b2 == e2); }
                    const int s1 = sbase[e1] + r1, sl2 = sbase[e2] + r2; const int tok = wu * 64 + lane;
                    permw[e1 * NTOK + s1] = tok; permw[e2 * NTOK + sl2] = tok;
                    TokInfo ti; ti.e1 = e1; ti.e2 = e2; ti.s1 = s1; ti.s2 = sl2; ti.g1 = rg[lane * 2]; ti.g2 = rg[lane * 2 + 1]; ti.pad0 = 0; ti.pad1 = 0;
                    info[tok] = ti;
                }
                __syncthreads();
            }
        }
        SEAM(pbase + PH_LNR);
        if (IN(pbase + PH_MOE1) || IN(pbase + PH_MOE2)) {
            LAS int* pb = (LAS int*)(lds + PB_OFF); LAS int* ul = pb + 32; LAS unsigned* tab = (LAS unsigned*)(lds + TAB_OFF);
            const int* cnt = (const int*)(ctl + CW_CNT + l * 16);
            __syncthreads();
            if (tid == 0) { int sacc = 0; for (int e = 0; e < 16; ++e) { pb[e] = sacc; sacc += (cnt[e] + 255) >> 8; } pb[16] = sacc; }
            __syncthreads();
#define MOE_ULIST(NT) do { if (tid < 8) { const int L = tid * G + vcu; const int okv = L < pb[16] * (NT); const int p = okv ? L / (NT) : 0; int e = 0; \
                for (int j = 1; j < 16; ++j) e += (pb[j] <= p) ? 1 : 0; ul[tid * 4] = p; ul[tid * 4 + 1] = L % (NT); ul[tid * 4 + 2] = e; ul[tid * 4 + 3] = okv; } __syncthreads(); } while (0)
            if (IN(pbase + PH_MOE1)) {
                MOE_ULIST(8);
#pragma unroll 1
                for (int i = 0; i < 8; ++i) {
                    if (ul[i * 4 + 3] && tid < 256) { const int e = ul[i * 4 + 2]; const int slot = (ul[i * 4] - pb[e]) * 256 + tid; const int c = cnt[e]; const int tok = perm[e * NTOK + (slot < c ? slot : 0)]; tab[i * 256 + tid] = (unsigned)tok * (unsigned)(DM * 2); }
                }
                __syncthreads();
                pg8::MoeSched S{ul, tab, (const char*)X1B, (const char*)Wgu_t, 0, (size_t)256 * DM * 2, (size_t)2 * FF * DM * 2};
                pg8::EpiSwiGLU E{HB};
                pg8::gemm_phase<pg8::EpiSwiGLU, pg8::MoeSched, true, true>(lds, DM, S, E);
            }
            SEAM(pbase + PH_MOE1);
            if (IN(pbase + PH_MOE2)) {
                MOE_ULIST(4);
                pg8::MoeSched S{ul, tab, (const char*)HB, (const char*)Wd_t, (size_t)256 * FF * 2, (size_t)256 * FF * 2, (size_t)DM * FF * 2};
                pg8::EpiPlain E{YP, DM};
                pg8::gemm_phase<pg8::EpiPlain, pg8::MoeSched, false, true>(lds, FF, S, E);
            }
#undef MOE_ULIST
        }
        SEAM(pbase + PH_MOE2);
        if (IN(pbase + PH_COMB)) {
            int tl = threadIdx.x; asm volatile("" : "+v"(tl)); const int lane = tl & 63, wave = __builtin_amdgcn_readfirstlane(tl >> 6);
            LAS int* pb = (LAS int*)(lds + PB_OFF);
            const int* cnt = (const int*)(ctl + CW_CNT + l * 16);
            __syncthreads();
            if (tl == 0) { int sacc = 0; for (int e = 0; e < 16; ++e) { pb[e] = sacc; sacc += (cnt[e] + 255) >> 8; } pb[16] = sacc; }
            __syncthreads();
            const float* X1 = (const float*)(ws + WS_X1); const TokInfo* info = (const TokInfo*)(ws + WS_INFO);
            const float* lg = args.in[7] + l * DM; const float* lb = args.in[8] + l * DM;
            const bool lastl = (l == DEPTH - 1);
            const int gw = vcu * NWAVES + wave, NGW = G * NWAVES;
            for (int tok = gw; tok < NTOK; tok += NGW) {
                const TokInfo ti = info[tok];
                const f32x4* xr = (const f32x4*)(X1 + (size_t)tok * DM) + lane;
                const u32x2* y1 = (const u32x2*)(YP + (size_t)(pb[ti.e1] * 256 + ti.s1) * DM) + lane;
                const u32x2* y2 = (const u32x2*)(YP + (size_t)(pb[ti.e2] * 256 + ti.s2) * DM) + lane;
                f32x4 v[4]; float s = 0.f;
#pragma unroll
                for (int j = 0; j < 4; ++j) { const f32x4 x = xr[64 * j]; const u32x2 a = y1[64 * j], c = y2[64 * j];
                    const f32x4 ya = (f32x4){__uint_as_float(a.x << 16), __uint_as_float(a.x & 0xffff0000u), __uint_as_float(a.y << 16), __uint_as_float(a.y & 0xffff0000u)};
                    const f32x4 yc = (f32x4){__uint_as_float(c.x << 16), __uint_as_float(c.x & 0xffff0000u), __uint_as_float(c.y << 16), __uint_as_float(c.y & 0xffff0000u)};
                    v[j] = x * ALPHA + (ya * ti.g1 + yc * ti.g2); s += (v[j].x + v[j].y) + (v[j].z + v[j].w); }
                const float mean = wave_sum(s) * (1.f / DM); float s2 = 0.f;
#pragma unroll
                for (int j = 0; j < 4; ++j) { v[j] = v[j] - mean; s2 += (v[j].x * v[j].x + v[j].y * v[j].y) + (v[j].z * v[j].z + v[j].w * v[j].w); }
                const float rstd = rsqrtf(wave_sum(s2) * (1.f / DM) + LN_EPS);
                f32x4* o4 = (f32x4*)((lastl ? args.out : XC) + (size_t)tok * DM) + lane; unsigned long long* o8 = (unsigned long long*)(XB + (size_t)tok * DM) + lane;
#pragma unroll
                for (int j = 0; j < 4; ++j) { const f32x4 gv = ((const f32x4*)lg)[lane + 64 * j], bv = ((const f32x4*)lb)[lane + 64 * j];
                    const f32x4 y = v[j] * rstd * gv + bv; o4[64 * j] = y;
                    if (!lastl) o8[64 * j] = (unsigned long long)pk2(y.x, y.y) | ((unsigned long long)pk2(y.z, y.w) << 32); }
            }
        }
        SEAM(pbase + PH_COMB);
    }
#undef IN
#undef SEAM
}

struct NGemm { const bf16_t* A; int lda; const int* rowmap; const int* cnt; const int* coff; const float* B; const float* B2; long bstride; int ldb; void* C; int ldc; int M; int K; const float* R; int pad; };
template <int MODE>
__global__ void __launch_bounds__(256) ngemm(NGemm g) {
    __shared__ float As[16][68];
    __shared__ float Bs[16][64];
    __shared__ float Bs2[MODE == 2 ? 16 : 1][64];
    const int z = blockIdx.z, tid = threadIdx.x;
    const int M = g.cnt ? g.cnt[z] : g.M;
    const int r0 = blockIdx.y * 64, n0 = blockIdx.x * 64;
    if (r0 >= M) return;
    const int cbase = g.coff ? g.coff[z] : 0;
    const float* B = g.B + (long)z * g.bstride;
    const float* B2 = MODE == 2 ? g.B2 + (long)z * g.bstride : nullptr;
    const int lr = tid >> 2, lk = (tid & 3) * 4;
    int rr = r0 + lr; if (rr >= M) rr = M - 1;
    const long arow = g.rowmap ? (long)g.rowmap[(long)z * NTOK + rr] : (long)(cbase + rr);
    const bf16_t* ap = g.A + arow * g.lda + lk;
    const int bk = tid >> 4, bn = (tid & 15) * 4;
    const int tx = tid & 15, ty = tid >> 4;
    float acc[4][4], acc2[4][4];
#pragma unroll
    for (int i = 0; i < 4; ++i)
#pragma unroll
        for (int j = 0; j < 4; ++j) { acc[i][j] = 0.f; acc2[i][j] = 0.f; }
    for (int k0 = 0; k0 < g.K; k0 += 16) {
        const u32x2 av = *(const u32x2*)(ap + k0);
        const float4 bv = *(const float4*)(B + (long)(k0 + bk) * g.ldb + n0 + bn);
        float4 bv2 = make_float4(0.f, 0.f, 0.f, 0.f);
        if (MODE == 2) bv2 = *(const float4*)(B2 + (long)(k0 + bk) * g.ldb + n0 + bn);
        __syncthreads();
        As[lk + 0][lr] = __uint_as_float(av.x << 16); As[lk + 1][lr] = __uint_as_float(av.x & 0xffff0000u); As[lk + 2][lr] = __uint_as_float(av.y << 16); As[lk + 3][lr] = __uint_as_float(av.y & 0xffff0000u);
        *(float4*)&Bs[bk][bn] = bv;
        if (MODE == 2) *(float4*)&Bs2[bk][bn] = bv2;
        __syncthreads();
#pragma unroll
        for (int k = 0; k < 16; ++k) {
            const float4 a = *(const float4*)&As[k][ty * 4];
            const float4 b = *(const float4*)&Bs[k][tx * 4];
            const float aa[4] = {a.x, a.y, a.z, a.w}, bb[4] = {b.x, b.y, b.z, b.w};
#pragma unroll
            for (int i = 0; i < 4; ++i)
#pragma unroll
                for (int j = 0; j < 4; ++j) acc[i][j] += aa[i] * bb[j];
            if (MODE == 2) {
                const float4 b2 = *(const float4*)&Bs2[k][tx * 4];
                const float bb2[4] = {b2.x, b2.y, b2.z, b2.w};
#pragma unroll
                for (int i = 0; i < 4; ++i)
#pragma unroll
                    for (int j = 0; j < 4; ++j) acc2[i][j] += aa[i] * bb2[j];
            }
        }
    }
#pragma unroll
    for (int i = 0; i < 4; ++i) {
        const int r = r0 + ty * 4 + i;
        if (r >= M) continue;
        float o[4];
        const int col = n0 + tx * 4;
#pragma unroll
        for (int j = 0; j < 4; ++j) {
            float v = acc[i][j];
            if (MODE == 0) { const int ct = col >> 8; if (ct < 2 || ct == 6 || ct == 7) v *= QSCALE; }
            if (MODE == 2) { const float gte = v; v = gte / (1.f + expf(-gte)) * acc2[i][j]; }
            o[j] = v;
        }
        const long crow = cbase + r;
        if (MODE == 1) {
            const float4 rv = *(const float4*)(g.R + crow * DM + col);
            *(float4*)((float*)g.C + crow * g.ldc + col) = make_float4(o[0] + ALPHA * rv.x, o[1] + ALPHA * rv.y, o[2] + ALPHA * rv.z, o[3] + ALPHA * rv.w);
        } else {
            u32x2 w; w.x = pk2(o[0], o[1]); w.y = pk2(o[2], o[3]);
            *(u32x2*)((bf16_t*)g.C + crow * g.ldc + col) = w;
        }
    }
}

__device__ __forceinline__ void ld8bf(const bf16_t* p, float* o) { const u32x4 v = *(const u32x4*)p;
    o[0] = __uint_as_float(v.x << 16); o[1] = __uint_as_float(v.x & 0xffff0000u); o[2] = __uint_as_float(v.y << 16); o[3] = __uint_as_float(v.y & 0xffff0000u);
    o[4] = __uint_as_float(v.z << 16); o[5] = __uint_as_float(v.z & 0xffff0000u); o[6] = __uint_as_float(v.w << 16); o[7] = __uint_as_float(v.w & 0xffff0000u); }

__global__ void __launch_bounds__(64) sb_attn_naive(const bf16_t* __restrict__ proj, const float* __restrict__ gain, bf16_t* __restrict__ Y) {
    __shared__ float Ks[64][64];
    __shared__ float Vs[64][64];
    const int lane = threadIdx.x, qb = blockIdx.x, h = blockIdx.y, b = blockIdx.z;
    const int t = qb * 64 + lane;
    const bf16_t* base = proj + (long)b * SEQ * NPROJ;
    float q[64], o[64];
    {
        const bf16_t* qp = base + (long)t * NPROJ + h * 64;
#pragma unroll
        for (int d = 0; d < 64; d += 8) { ld8bf(qp + d, q + d); }
#pragma unroll
        for (int d = 0; d < 64; ++d) { q[d] *= LN2; o[d] = 0.f; }
    }
    float R = 0.f;
    for (int kt = qb; kt >= 0; --kt) {
        __syncthreads();
#pragma unroll
        for (int it = 0; it < 8; ++it) {
            const int row = it * 8 + (lane >> 3), c8 = (lane & 7) * 8;
            const bf16_t* kp = base + (long)(kt * 64 + row) * NPROJ + 512 + h * 64 + c8;
            float tmp[8]; ld8bf(kp, tmp);
#pragma unroll
            for (int j = 0; j < 8; ++j) Ks[row][c8 + j] = tmp[j];
            ld8bf(kp + 512, tmp);
#pragma unroll
            for (int j = 0; j < 8; ++j) Vs[row][c8 + j] = tmp[j];
        }
        __syncthreads();
        for (int j = 63; j >= 0; --j) {
            const int kj = kt * 64 + j;
            float z = 0.f;
#pragma unroll
            for (int d = 0; d < 64; d += 4) { const float4 kv = *(const float4*)&Ks[j][d]; z += q[d] * kv.x + q[d + 1] * kv.y + q[d + 2] * kv.z + q[d + 3] * kv.w; }
            const float sp = fmaxf(z, 0.f) + log1pf(expf(-fabsf(z)));
            const bool valid = kj < t;
            const float a = valid ? expf(z - sp + R) : 0.f;
            if (valid) R -= sp;
#pragma unroll
            for (int d = 0; d < 64; d += 4) { const float4 vv = *(const float4*)&Vs[j][d]; o[d] += a * vv.x; o[d + 1] += a * vv.y; o[d + 2] += a * vv.z; o[d + 3] += a * vv.w; }
        }
        if (__all(R < -110.f)) break;
    }
    float ss = 0.f;
#pragma unroll
    for (int d = 0; d < 64; ++d) ss += o[d] * o[d];
    const float rs = rsqrtf(ss * (1.f / 64.f) + 1e-6f);
    bf16_t* yp = Y + ((long)b * SEQ + t) * DM + h * 64;
#pragma unroll
    for (int d = 0; d < 64; d += 4) {
        const float4 gv = *(const float4*)(gain + h * 64 + d);
        u32x2 w; w.x = pk2(o[d] * rs * gv.x, o[d + 1] * rs * gv.y); w.y = pk2(o[d + 2] * rs * gv.z, o[d + 3] * rs * gv.w);
        *(u32x2*)(yp + d) = w;
    }
}
__global__ void __launch_bounds__(64) dil_attn_naive(const bf16_t* __restrict__ proj, const float* __restrict__ rel_bias, const float* __restrict__ gain, bf16_t* __restrict__ Y) {
    __shared__ float bt[32];
    const int lane = threadIdx.x, h = blockIdx.y, b = blockIdx.z;
    const int t = blockIdx.x * 64 + lane;
    if (lane < 32) bt[lane] = rel_bias[lane * 8 + h];
    __syncthreads();
    const bf16_t* base = proj + (long)b * SEQ * NPROJ;
    float q[64], o[64];
    {
        const bf16_t* qp = base + (long)t * NPROJ + 1536 + h * 64;
#pragma unroll
        for (int d = 0; d < 64; d += 8) ld8bf(qp + d, q + d);
#pragma unroll
        for (int d = 0; d < 64; ++d) { q[d] *= LN2; o[d] = 0.f; }
    }
    float m = -1e30f, l = 0.f;
    for (int br = 0; br < 3; ++br) {
        const int dil = br == 0 ? 1 : (br == 1 ? 4 : 16);
        for (int st = 0; st <= 128; ++st) {
            const int j = t - st * dil;
            if (j < 0) break;
            const bf16_t* kp = base + (long)j * NPROJ + 2048 + h * 64;
            float z = 0.f;
#pragma unroll
            for (int d = 0; d < 64; d += 8) { float kv[8]; ld8bf(kp + d, kv);
#pragma unroll
                for (int jj = 0; jj < 8; ++jj) z += q[d + jj] * kv[jj]; }
            z += bt[t5_bucket(st * dil)];
            const float mn = fmaxf(m, z), sc = expf(m - mn), p = expf(z - mn);
            l = l * sc + p; m = mn;
            const bf16_t* vp = kp + 512;
#pragma unroll
            for (int d = 0; d < 64; d += 8) { float vv[8]; ld8bf(vp + d, vv);
#pragma unroll
                for (int jj = 0; jj < 8; ++jj) o[d + jj] = o[d + jj] * sc + p * vv[jj]; }
        }
    }
    const float il = 1.f / l;
    float ss = 0.f;
#pragma unroll
    for (int d = 0; d < 64; ++d) { o[d] *= il; ss += o[d] * o[d]; }
    const float rs = rsqrtf(ss * (1.f / 64.f) + 1e-6f);
    bf16_t* yp = Y + ((long)b * SEQ + t) * DM + 512 + h * 64;
#pragma unroll
    for (int d = 0; d < 64; d += 4) {
        const float4 gv = *(const float4*)(gain + h * 64 + d);
        u32x2 w; w.x = pk2(o[d] * rs * gv.x, o[d + 1] * rs * gv.y); w.y = pk2(o[d + 2] * rs * gv.z, o[d + 3] * rs * gv.w);
        *(u32x2*)(yp + d) = w;
    }
}
__global__ void __launch_bounds__(256) ln_route_naive(const float* __restrict__ T, const float* __restrict__ g, const float* __restrict__ bb, float* __restrict__ X1, bf16_t* __restrict__ X1B,
                                                      const float* __restrict__ wr, const float* __restrict__ br, int* __restrict__ cnt, int* __restrict__ perm, TokInfo* __restrict__ info) {
    const int lane = threadIdx.x & 63, row = blockIdx.x * 4 + (threadIdx.x >> 6);
    const float4* xr = (const float4*)(T + (long)row * DM) + lane;
    float4 v[4]; float s = 0.f;
#pragma unroll
    for (int j = 0; j < 4; ++j) { v[j] = xr[64 * j]; s += (v[j].x + v[j].y) + (v[j].z + v[j].w); }
    const float mean = wave_sum(s) * (1.f / DM); float s2 = 0.f;
#pragma unroll
    for (int j = 0; j < 4; ++j) { v[j].x -= mean; v[j].y -= mean; v[j].z -= mean; v[j].w -= mean; s2 += (v[j].x * v[j].x + v[j].y * v[j].y) + (v[j].z * v[j].z + v[j].w * v[j].w); }
    const float rstd = rsqrtf(wave_sum(s2) * (1.f / DM) + LN_EPS);
    float4* o4 = (float4*)(X1 + (long)row * DM) + lane; unsigned long long* o8 = (unsigned long long*)(X1B + (long)row * DM) + lane;
    float acc[16];
#pragma unroll
    for (int e = 0; e < 16; ++e) acc[e] = 0.f;
#pragma unroll
    for (int j = 0; j < 4; ++j) {
        const float4 gv = ((const float4*)g)[lane + 64 * j], bv = ((const float4*)bb)[lane + 64 * j];
        const float4 y = make_float4(v[j].x * rstd * gv.x + bv.x, v[j].y * rstd * gv.y + bv.y, v[j].z * rstd * gv.z + bv.z, v[j].w * rstd * gv.w + bv.w);
        o4[64 * j] = y; o8[64 * j] = (unsigned long long)pk2(y.x, y.y) | ((unsigned long long)pk2(y.z, y.w) << 32);
        const float yy[4] = {y.x, y.y, y.z, y.w};
#pragma unroll
        for (int c = 0; c < 4; ++c) { const float4* w4 = (const float4*)(wr + (long)(4 * lane + 256 * j + c) * 16);
#pragma unroll
            for (int e4 = 0; e4 < 4; ++e4) { const float4 w = w4[e4]; acc[e4 * 4] += yy[c] * w.x; acc[e4 * 4 + 1] += yy[c] * w.y; acc[e4 * 4 + 2] += yy[c] * w.z; acc[e4 * 4 + 3] += yy[c] * w.w; } }
    }
    float mx = -1e30f;
#pragma unroll
    for (int e = 0; e < 16; ++e) { acc[e] = wave_sum(acc[e]) + br[e]; mx = fmaxf(mx, acc[e]); }
    float p[16];
#pragma unroll
    for (int e = 0; e < 16; ++e) p[e] = expf(acc[e] - mx);
    float best = -1.f; int be1 = 0, be2 = 0; float bv1 = 0.f, bv2 = 0.f;
#pragma unroll
    for (int gI = 0; gI < 4; ++gI) {
        float v1 = -1.f, v2 = -1.f; int i1 = 0, i2 = 0;
#pragma unroll
        for (int j = 0; j < 4; ++j) { const float pv = p[gI * 4 + j];
            if (pv > v1) { v2 = v1; i2 = i1; v1 = pv; i1 = j; } else if (pv > v2) { v2 = pv; i2 = j; } }
        const float sm = v1 + v2;
        if (sm > best) { best = sm; be1 = gI * 4 + i1; be2 = gI * 4 + i2; bv1 = v1; bv2 = v2; }
    }
    if (lane == 0) {
        const int s1 = atomicAdd(&cnt[be1], 1), sl2 = atomicAdd(&cnt[be2], 1);
        perm[be1 * NTOK + s1] = row; perm[be2 * NTOK + sl2] = row;
        TokInfo ti; ti.e1 = be1; ti.e2 = be2; ti.s1 = s1; ti.s2 = sl2; ti.g1 = bv1 / (bv1 + bv2); ti.g2 = bv2 / (bv1 + bv2); ti.pad0 = 0; ti.pad1 = 0;
        info[row] = ti;
    }
}
__global__ void scan16(const int* __restrict__ cnt, int* __restrict__ off) {
    if (threadIdx.x == 0) { int s = 0; for (int e = 0; e < 16; ++e) { off[e] = s; s += ((cnt[e] + 255) >> 8) << 8; } }
}
__global__ void __launch_bounds__(256) combine_naive(const float* __restrict__ X1, const bf16_t* __restrict__ YP, const TokInfo* __restrict__ info, const int* __restrict__ cnt,
                                                     const float* __restrict__ g, const float* __restrict__ bb, float* __restrict__ out, bf16_t* __restrict__ outb) {
    const int lane = threadIdx.x & 63, row = blockIdx.x * 4 + (threadIdx.x >> 6);
    const TokInfo ti = info[row];
    int off1 = 0, off2 = 0;
    for (int e = 0; e < 16; ++e) { const int pc = ((cnt[e] + 255) >> 8) << 8; if (e < ti.e1) off1 += pc; if (e < ti.e2) off2 += pc; }
    const float4* xr = (const float4*)(X1 + (long)row * DM) + lane;
    const u32x2* y1 = (const u32x2*)(YP + (long)(off1 + ti.s1) * DM) + lane;
    const u32x2* y2 = (const u32x2*)(YP + (long)(off2 + ti.s2) * DM) + lane;
    float4 v[4]; float s = 0.f;
#pragma unroll
    for (int j = 0; j < 4; ++j) {
        const float4 x = xr[64 * j]; const u32x2 a = y1[64 * j], c = y2[64 * j];
        v[j].x = ALPHA * x.x + (ti.g1 * __uint_as_float(a.x << 16) + ti.g2 * __uint_as_float(c.x << 16));
        v[j].y = ALPHA * x.y + (ti.g1 * __uint_as_float(a.x & 0xffff0000u) + ti.g2 * __uint_as_float(c.x & 0xffff0000u));
        v[j].z = ALPHA * x.z + (ti.g1 * __uint_as_float(a.y << 16) + ti.g2 * __uint_as_float(c.y << 16));
        v[j].w = ALPHA * x.w + (ti.g1 * __uint_as_float(a.y & 0xffff0000u) + ti.g2 * __uint_as_float(c.y & 0xffff0000u));
        s += (v[j].x + v[j].y) + (v[j].z + v[j].w);
    }
    const float mean = wave_sum(s) * (1.f / DM); float s2 = 0.f;
#pragma unroll
    for (int j = 0; j < 4; ++j) { v[j].x -= mean; v[j].y -= mean; v[j].z -= mean; v[j].w -= mean; s2 += (v[j].x * v[j].x + v[j].y * v[j].y) + (v[j].z * v[j].z + v[j].w * v[j].w); }
    const float rstd = rsqrtf(wave_sum(s2) * (1.f / DM) + LN_EPS);
    float4* o4 = (float4*)(out + (long)row * DM) + lane; unsigned long long* o8 = (unsigned long long*)(outb + (long)row * DM) + lane;
#pragma unroll
    for (int j = 0; j < 4; ++j) {
        const float4 gv = ((const float4*)g)[lane + 64 * j], bv = ((const float4*)bb)[lane + 64 * j];
        const float4 y = make_float4(v[j].x * rstd * gv.x + bv.x, v[j].y * rstd * gv.y + bv.y, v[j].z * rstd * gv.z + bv.z, v[j].w * rstd * gv.w + bv.w);
        o4[64 * j] = y; o8[64 * j] = (unsigned long long)pk2(y.x, y.y) | ((unsigned long long)pk2(y.z, y.w) << 32);
    }
}

static void launch_mk(Args a, int lo, int hi, int grid, hipStream_t stream) {
    a.ph_lo = lo; a.ph_hi = hi;
    hipLaunchKernelGGL(mk, dim3(grid), dim3(NWAVES * 64), LDS_BYTES, stream, a);
}
extern "C" void kernel_launch(void* const* d_in, const int* in_sizes, int n_in, void* d_out, int out_size, void* d_ws, size_t ws_size, hipStream_t stream) {
    static int grid = 0;
    if (grid == 0) {
        if (n_in != 15 || ws_size < WS_END) { fprintf(stderr, "kernel_launch: unexpected n_in %d / ws %zu\n", n_in, ws_size); grid = -1; return; }
        if (hipFuncSetAttribute((const void*)mk, hipFuncAttributeMaxDynamicSharedMemorySize, LDS_BYTES) != hipSuccess) { fprintf(stderr, "hipFuncSetAttribute failed\n"); grid = -1; return; }
        int dev = 0, cus = 0; (void)hipGetDevice(&dev); (void)hipDeviceGetAttribute(&cus, hipDeviceAttributeMultiprocessorCount, dev);
        grid = cus > 0 ? cus : 256;
    }
    if (grid < 0) return;
    (void)hipMemsetAsync((char*)d_ws + WS_CTL, 0, CTL_ZERO_BYTES, stream);
    Args a{};
    for (int i = 0; i < 15; ++i) a.in[i] = (const float*)d_in[i];
    a.out = (float*)d_out; a.ws = (unsigned char*)d_ws;
    char* ws = (char*)d_ws;
    const float* x = a.in[0]; const float* w_in = a.in[1]; const float* g_sb = a.in[2]; const float* g_dil = a.in[3]; const float* w_out = a.in[4];
    const float* ln1_g = a.in[5]; const float* ln1_b = a.in[6]; const float* ln2_g = a.in[7]; const float* ln2_b = a.in[8]; const float* rel_bias = a.in[9];
    const float* w_router = a.in[10]; const float* b_router = a.in[11]; const float* w_gate = a.in[12]; const float* w_up = a.in[13]; const float* w_down = a.in[14];
    int* ctl = (int*)(ws + WS_CTL); int* perm = (int*)(ws + WS_PERM); TokInfo* info = (TokInfo*)(ws + WS_INFO);
    bf16_t* XB = (bf16_t*)(ws + WS_XB); float* XC = (float*)(ws + WS_XC); bf16_t* PROJ = (bf16_t*)(ws + WS_PROJ); bf16_t* HB = (bf16_t*)(ws + WS_H);
    bf16_t* Y = (bf16_t*)(ws + WS_Y); float* T = (float*)(ws + WS_T); bf16_t* YP = (bf16_t*)(ws + WS_YP); float* X1 = (float*)(ws + WS_X1); bf16_t* X1B = (bf16_t*)(ws + WS_X1B);
    for (int l = 0; l < DEPTH; ++l) {
        const int pb = l * PH_PER_LAYER;
        int* cntl = ctl + CW_CNT + l * 16; int* offl = ctl + CW_OFF + l * 16;
        const float* xres = l == 0 ? x : XC;
        launch_mk(a, pb + PH_W, pb + PH_W + 1, grid, stream);
#if FAST_GEMM
        launch_mk(a, pb + PH_QKV, pb + PH_QKV + 1, grid, stream);
#else
        { NGemm g{}; g.A = XB; g.lda = DM; g.B = w_in + (size_t)l * DM * NPROJ; g.ldb = NPROJ; g.C = PROJ; g.ldc = NPROJ; g.M = NTOK; g.K = DM;
          hipLaunchKernelGGL(ngemm<0>, dim3(NPROJ / 64, NTOK / 64, 1), dim3(256), 0, stream, g); }
#endif
#if FAST_ATT
        launch_mk(a, pb + PH_ATT, pb + PH_ATT + 1, grid, stream);
#else
        hipLaunchKernelGGL(sb_attn_naive, dim3(SEQ / 64, 8, BATCH), dim3(64), 0, stream, PROJ, g_sb + l * 512, Y);
        hipLaunchKernelGGL(dil_attn_naive, dim3(SEQ / 64, 8, BATCH), dim3(64), 0, stream, PROJ, rel_bias, g_dil + l * 512, Y);
#endif
#if FAST_GEMM
        launch_mk(a, pb + PH_OUT, pb + PH_OUT + 1, grid, stream);
#else
        { NGemm g{}; g.A = Y; g.lda = DM; g.B = w_out + (size_t)l * DM * DM; g.ldb = DM; g.C = T; g.ldc = DM; g.M = NTOK; g.K = DM; g.R = xres;
          hipLaunchKernelGGL(ngemm<1>, dim3(DM / 64, NTOK / 64, 1), dim3(256), 0, stream, g); }
#endif
#if FAST_THIN
        launch_mk(a, pb + PH_LNR, pb + PH_LNR + 1, grid, stream);
#else
        hipLaunchKernelGGL(ln_route_naive, dim3(NTOK / 4), dim3(256), 0, stream, T, ln1_g + l * DM, ln1_b + l * DM, X1, X1B, w_router, b_router, cntl, perm, info);
#endif
#if FAST_GEMM
        launch_mk(a, pb + PH_MOE1, pb + PH_MOE1 + 1, grid, stream);
        launch_mk(a, pb + PH_MOE2, pb + PH_MOE2 + 1, grid, stream);
#else
        hipLaunchKernelGGL(scan16, dim3(1), dim3(64), 0, stream, cntl, offl);
        { NGemm g{}; g.A = X1B; g.lda = DM; g.rowmap = perm; g.cnt = cntl; g.coff = offl;
          g.B = w_gate + (size_t)l * NEXP * DM * FF; g.B2 = w_up + (size_t)l * NEXP * DM * FF; g.bstride = (long)DM * FF; g.ldb = FF; g.C = HB; g.ldc = FF; g.M = NTOK; g.K = DM;
          hipLaunchKernelGGL(ngemm<2>, dim3(FF / 64, NTOK / 64, NEXP), dim3(256), 0, stream, g); }
        { NGemm g{}; g.A = HB; g.lda = FF; g.cnt = cntl; g.coff = offl;
          g.B = w_down + (size_t)l * NEXP * FF * DM; g.bstride = (long)FF * DM; g.ldb = DM; g.C = YP; g.ldc = DM; g.M = NTOK; g.K = FF;
          hipLaunchKernelGGL(ngemm<3>, dim3(DM / 64, NTOK / 64, NEXP), dim3(256), 0, stream, g); }
#endif
#if FAST_THIN
        launch_mk(a, pb + PH_COMB, pb + PH_COMB + 1, grid, stream);
#else
        float* xo = (l == DEPTH - 1) ? (float*)d_out : XC;
        hipLaunchKernelGGL(combine_naive, dim3(NTOK / 4), dim3(256), 0, stream, X1, YP, info, cntl, ln2_g + l * DM, ln2_b + l * DM, xo, XB);
#endif
    }
}
```

```cpp
#include <hip/hip_runtime.h>
#include <cstdio>
#include <cstdint>

constexpr int BATCH = 2, SEQ = 8192, DM = 1024, NTOK = BATCH * SEQ, NPROJ = 3072, NEXP = 16, DEPTH = 2, FF = 1024;
constexpr float ALPHA = 1.4142135623730951f;
constexpr float LN_EPS = 1e-5f;
constexpr float LOG2E = 1.4426950408889634f, LN2 = 0.6931471805599453f;
constexpr float QSCALE = 0.125f * LOG2E;

#ifndef FAST_GEMM
#define FAST_GEMM 1
#endif
#ifndef FAST_ATT
#define FAST_ATT 1
#endif
#ifndef FAST_THIN
#define FAST_THIN 1
#endif
#ifndef ONE_LAUNCH
#define ONE_LAUNCH 1
#endif

typedef unsigned short bf16_t;
#define LAS __attribute__((address_space(3)))
#define GAS __attribute__((address_space(1)))
typedef float f32x4 __attribute__((ext_vector_type(4)));
typedef float f32x2 __attribute__((ext_vector_type(2)));
typedef float f32x16 __attribute__((ext_vector_type(16)));
typedef short bf16x8 __attribute__((ext_vector_type(8)));
typedef unsigned u32x4 __attribute__((ext_vector_type(4)));
typedef unsigned u32x2 __attribute__((ext_vector_type(2)));

__device__ __forceinline__ float bf2f(bf16_t v) { return __uint_as_float((unsigned)v << 16); }
__device__ __forceinline__ unsigned f2bf(float f) { unsigned u = __float_as_uint(f); return (u + 0x7fffu + ((u >> 16) & 1u)) >> 16; }
__device__ __forceinline__ unsigned pk2(float lo, float hi) { return f2bf(lo) | (f2bf(hi) << 16); }
__device__ __forceinline__ unsigned cvt_pk_bf16(float lo, float hi) { unsigned r; asm volatile("v_cvt_pk_bf16_f32 %0, %1, %2" : "=v"(r) : "v"(lo), "v"(hi)); return r; }

constexpr size_t MiB = 1u << 20;
constexpr size_t WS_CTL = 0, CTL_ZERO_BYTES = 65536;
constexpr size_t WS_PERM = 1 * MiB, WS_INFO = 2 * MiB;
constexpr size_t WS_WIN = 4 * MiB, WS_WOUT = 10 * MiB, WS_WGU = 12 * MiB, WS_WD = 76 * MiB;
constexpr size_t WS_XB = 108 * MiB, WS_XC = 140 * MiB, WS_PROJ = 204 * MiB, WS_H = 204 * MiB;
constexpr size_t WS_Y = 300 * MiB, WS_T = 332 * MiB, WS_YP = 300 * MiB, WS_X1 = 396 * MiB, WS_X1B = 460 * MiB, WS_END = 492 * MiB;
constexpr int CW_TMO = 0, CW_CNT = 64  , CW_OFF = 128  , CW_BAR = 1024;

struct TokInfo { int e1, e2, s1, s2; float g1, g2; int pad0, pad1; };

namespace pg8 {
constexpr int BM = 256, BK = 64, HALF = 128, HTB = HALF * BK * 2, STAGE_BYTES = 8 * HTB;
__host__ __device__ __forceinline__ int lds_byte(int r, int c) { const int st = (r >> 4) * 2 + (c >> 5), rr = r & 15, cc = c & 31, ob = rr * 64 + cc * 2; return st * 1024 + (ob ^ (((ob >> 9) & 1) << 5)); }
__host__ __device__ __forceinline__ void stage_rc(int b, int& R, int& C) { const int st = b / 1024, sb = b % 1024, swz = sb ^ (((sb >> 9) & 1) << 5); R = (st >> 1) * 16 + swz / 64; C = (st & 1) * 32 + (swz % 64) / 2; }
__host__ __device__ __forceinline__ int perm32(int rho) { const int n = rho >> 4, i = rho & 15; return 8 * (i >> 2) + 4 * n + (i & 3); }

struct Unit { int pm, pn, e; };

struct EpiProj {
    static constexpr bool PERM = true;
    bf16_t* O;
    __device__ __forceinline__ void operator()(const f32x4 (&acc)[2][2][4][2], const Unit& u, int wr, int wc, int fr, int fq) const {
        const int row0 = u.pm * BM + wr * 64 + fr; const int col0 = u.pn * BM + wc * 32 + 8 * fq;
        const float sc = (u.pn < 2 || u.pn == 6 || u.pn == 7) ? QSCALE : 1.f;
#pragma unroll
        for (int ai = 0; ai < 2; ++ai)
#pragma unroll
            for (int m = 0; m < 4; ++m) { bf16_t* rowp = O + (size_t)(row0 + ai * HALF + m * 16) * NPROJ + col0;
#pragma unroll
                for (int bj = 0; bj < 2; ++bj) { const f32x4 v0 = acc[ai][bj][m][0] * sc, v1 = acc[ai][bj][m][1] * sc;
                    u32x4 w; w.x = cvt_pk_bf16(v0[0], v0[1]); w.y = cvt_pk_bf16(v0[2], v0[3]); w.z = cvt_pk_bf16(v1[0], v1[1]); w.w = cvt_pk_bf16(v1[2], v1[3]);
                    *(u32x4*)(rowp + bj * HALF) = w; } }
    }
};
struct EpiPlain {
    static constexpr bool PERM = true;
    bf16_t* O; int ldc;
    __device__ __forceinline__ void operator()(const f32x4 (&acc)[2][2][4][2], const Unit& u, int wr, int wc, int fr, int fq) const {
        const int row0 = u.pm * BM + wr * 64 + fr; const int col0 = u.pn * BM + wc * 32 + 8 * fq;
#pragma unroll
        for (int ai = 0; ai < 2; ++ai)
#pragma unroll
            for (int m = 0; m < 4; ++m) { bf16_t* rowp = O + (size_t)(row0 + ai * HALF + m * 16) * ldc + col0;
#pragma unroll
                for (int bj = 0; bj < 2; ++bj) { const f32x4 v0 = acc[ai][bj][m][0], v1 = acc[ai][bj][m][1];
                    u32x4 w; w.x = cvt_pk_bf16(v0[0], v0[1]); w.y = cvt_pk_bf16(v0[2], v0[3]); w.z = cvt_pk_bf16(v1[0], v1[1]); w.w = cvt_pk_bf16(v1[2], v1[3]);
                    *(u32x4*)(rowp + bj * HALF) = w; } }
    }
};
struct EpiRes {
    static constexpr bool PERM = false;
    const float* X; float* T;
    __device__ __forceinline__ void operator()(const f32x4 (&acc)[2][2][4][2], const Unit& u, int wr, int wc, int fr, int fq) const {
        const int col0 = u.pn * BM + wc * 32 + 4 * fq;
#pragma unroll
        for (int ai = 0; ai < 2; ++ai)
#pragma unroll
            for (int m = 0; m < 4; ++m) { const size_t off = (size_t)(u.pm * BM + ai * HALF + wr * 64 + m * 16 + fr) * DM + col0;
#pragma unroll
                for (int bj = 0; bj < 2; ++bj)
#pragma unroll
                    for (int n = 0; n < 2; ++n) { const f32x4 xv = *(const f32x4*)(X + off + bj * HALF + n * 16); *(f32x4*)(T + off + bj * HALF + n * 16) = xv * ALPHA + acc[ai][bj][m][n]; } }
    }
};
struct EpiSwiGLU {
    static constexpr bool PERM = true;
    bf16_t* O;
    __device__ __forceinline__ void operator()(const f32x4 (&acc)[2][2][4][2], const Unit& u, int wr, int wc, int fr, int fq) const {
        const int row0 = u.pm * BM + wr * 64 + fr; const int col0 = u.pn * HALF + wc * 32 + 8 * fq;
#pragma unroll
        for (int ai = 0; ai < 2; ++ai)
#pragma unroll
            for (int m = 0; m < 4; ++m) { bf16_t* rowp = O + (size_t)(row0 + ai * HALF + m * 16) * FF + col0;
                float h[8];
#pragma unroll
                for (int n = 0; n < 2; ++n)
#pragma unroll
                    for (int j = 0; j < 4; ++j) { const float g = acc[ai][0][m][n][j], up = acc[ai][1][m][n][j];
                        h[n * 4 + j] = g * __builtin_amdgcn_rcpf(1.f + __builtin_amdgcn_exp2f(-g * LOG2E)) * up; }
                u32x4 w; w.x = cvt_pk_bf16(h[0], h[1]); w.y = cvt_pk_bf16(h[2], h[3]); w.z = cvt_pk_bf16(h[4], h[5]); w.w = cvt_pk_bf16(h[6], h[7]);
                *(u32x4*)rowp = w; }
    }
};

template <class Epi, class Sched, bool GATHER, bool ALIGN_EPI>
__device__ __forceinline__ void gemm_phase(LAS unsigned char* lds, const int K, const Sched& S, const Epi& E) {
    int tid_l = threadIdx.x; asm volatile("" : "+v"(tid_l));
    const int tid = tid_l, wid = __builtin_amdgcn_readfirstlane(tid >> 6), lane = tid & 63, wr = wid >> 2, wc = wid & 3, fr = lane & 15, fq = lane >> 4;
    const int nt = K / BK;
    unsigned voffA[2], voffB[2]; int gR[2];
#pragma unroll
    for (int i = 0; i < 2; ++i) { int R, C; stage_rc(tid * 16 + i * 8192, R, C); const int Rb = Epi::PERM ? ((R & ~31) + perm32(R & 31)) : R;
        voffA[i] = GATHER ? (unsigned)(C * 2) : (unsigned)(R * K + C) * 2u; voffB[i] = (unsigned)(Rb * K + C) * 2u; gR[i] = R; }
    const size_t kstep = (size_t)(BK * 2);
    const size_t hstep = (size_t)HALF * K * 2;
    const unsigned ldsw = (unsigned)wid * 1024u;
    const int aoff = lds_byte(wr * 64 + fr, fq * 8), boff = lds_byte(wc * 32 + fr, fq * 8);
    unsigned goff[2][2];
#define PG8_SA(b, h) (((b) * 2 + (h)) * HTB)
#define PG8_SB(b, h) ((4 + (b) * 2 + (h)) * HTB)
#define PG8_GLDS(gp, bufoff, i) __builtin_amdgcn_global_load_lds((const unsigned*)(gp), (LAS unsigned*)(lds + (bufoff) + ldsw + (i) * 8192), 16, 0, 0)
#define PG8_STAGE_B(bufoff, gbase) do { _Pragma("unroll") for (int _i = 0; _i < 2; ++_i) PG8_GLDS((const char*)(gbase) + voffB[_i], bufoff, _i); } while (0)
#define PG8_STAGE_A(bufoff, gbase, h) do { _Pragma("unroll") for (int _i = 0; _i < 2; ++_i) { \
        if constexpr (GATHER) PG8_GLDS((const char*)(gbase) + goff[h][_i], bufoff, _i); else PG8_GLDS((const char*)(gbase) + (size_t)(h) * hstep + voffA[_i], bufoff, _i); } } while (0)
#define PG8_LDA(dst, b, h) do { _Pragma("unroll") for (int m = 0; m < 4; ++m) _Pragma("unroll") for (int k = 0; k < 2; ++k) dst[m][k] = *(const LAS bf16x8*)(lds + PG8_SA(b, h) + aoff + m * 2048 + k * 1024); } while (0)
#define PG8_LDB(dst, b, h) do { _Pragma("unroll") for (int n = 0; n < 2; ++n) _Pragma("unroll") for (int k = 0; k < 2; ++k) dst[n][k] = *(const LAS bf16x8*)(lds + PG8_SB(b, h) + boff + n * 2048 + k * 1024); } while (0)
#define PG8_MMA(ai, bj, At, Bt) do { __builtin_amdgcn_s_setprio(1); _Pragma("unroll") for (int m = 0; m < 4; ++m) _Pragma("unroll") for (int n = 0; n < 2; ++n) _Pragma("unroll") for (int k = 0; k < 2; ++k) \
        acc[ai][bj][m][n] = __builtin_amdgcn_mfma_f32_16x16x32_bf16(Bt[n][k], At[m][k], acc[ai][bj][m][n], 0, 0, 0); __builtin_amdgcn_s_setprio(0); } while (0)
#define PG8_WAIT_V(n) asm volatile("s_waitcnt vmcnt(" #n ")" ::: "memory")
#define PG8_WAIT_L(n) asm volatile("s_waitcnt lgkmcnt(" #n ")" ::: "memory")
#define PG8_BAR __builtin_amdgcn_s_barrier()
#define PG8_SCHED __builtin_amdgcn_sched_barrier(0)
#define PG8_GOFF(uidx) do { if constexpr (GATHER) { _Pragma("unroll") for (int _h = 0; _h < 2; ++_h) _Pragma("unroll") for (int _i = 0; _i < 2; ++_i) goff[_h][_i] = S.grow(uidx, _h * HALF + gR[_i]) + voffA[_i]; } } while (0)
    Unit cur, nxt; int ui = 0;
    if (!S.next(0, cur)) return;
    f32x4 acc[2][2][4][2];
#pragma unroll
    for (int a = 0; a < 2; ++a)
#pragma unroll
        for (int b = 0; b < 2; ++b)
#pragma unroll
            for (int m = 0; m < 4; ++m)
#pragma unroll
                for (int n = 0; n < 2; ++n) acc[a][b][m][n] = (f32x4){0.f, 0.f, 0.f, 0.f};
    bf16x8 At[4][2], B0[2][2], B1[2][2];
    const char* cA = S.a_base(cur); const char* cB = S.b_base(cur);
    PG8_GOFF(0);
    PG8_STAGE_B(PG8_SB(0, 0), cB); PG8_STAGE_B(PG8_SB(0, 1), cB + hstep); PG8_STAGE_A(PG8_SA(0, 0), cA, 0); PG8_STAGE_A(PG8_SA(0, 1), cA, 1);
    if (wr == 1) PG8_BAR;
    PG8_WAIT_V(2); PG8_BAR;
    PG8_STAGE_B(PG8_SB(1, 0), cB + kstep); PG8_STAGE_A(PG8_SA(1, 0), cA + kstep, 0); PG8_STAGE_B(PG8_SB(1, 1), cB + hstep + kstep);
    PG8_WAIT_V(6); PG8_BAR;
    for (;;) {
        const bool has_next = S.next(ui + 1, nxt);
        const char* nA = has_next ? S.a_base(nxt) : cA; const char* nB = has_next ? S.b_base(nxt) : cB;
        for (int t = 0; t < nt; t += 2) {
            const bool last = (t == nt - 2);
            const char* a1 = cA + (size_t)(t + 1) * kstep;
            const char* a2 = last ? nA : cA + (size_t)(t + 2) * kstep; const char* b2 = last ? nB : cB + (size_t)(t + 2) * kstep;
            const char* a3 = a2 + kstep; const char* b3 = b2 + kstep;
            PG8_LDB(B0, 0, 0); PG8_LDB(B1, 0, 1); PG8_SCHED; PG8_LDA(At, 0, 0); PG8_STAGE_A(PG8_SA(1, 1), a1, 1);
            if (GATHER && last && has_next) { PG8_GOFF(ui + 1); }
            PG8_WAIT_V(8); PG8_WAIT_L(0); PG8_BAR; PG8_MMA(0, 0, At, B0); PG8_MMA(0, 1, At, B1); PG8_BAR; PG8_SCHED;
            PG8_LDA(At, 0, 1); PG8_STAGE_B(PG8_SB(0, 0), b2); PG8_STAGE_B(PG8_SB(0, 1), b2 + hstep); PG8_STAGE_A(PG8_SA(0, 0), a2, 0);
            PG8_WAIT_V(8); PG8_WAIT_L(0); PG8_BAR; PG8_MMA(1, 0, At, B0); PG8_MMA(1, 1, At, B1); PG8_BAR; PG8_SCHED;
            PG8_LDB(B0, 1, 0); PG8_LDB(B1, 1, 1); PG8_SCHED; PG8_LDA(At, 1, 0); PG8_STAGE_A(PG8_SA(0, 1), a2, 1);
            PG8_WAIT_V(8); PG8_WAIT_L(0); PG8_BAR; PG8_MMA(0, 0, At, B0); PG8_MMA(0, 1, At, B1); PG8_BAR; PG8_SCHED;
            PG8_LDA(At, 1, 1); PG8_STAGE_B(PG8_SB(1, 0), b3); PG8_STAGE_B(PG8_SB(1, 1), b3 + hstep); PG8_STAGE_A(PG8_SA(1, 0), a3, 0);
            PG8_WAIT_V(8); PG8_WAIT_L(0); PG8_BAR; PG8_MMA(1, 0, At, B0); PG8_MMA(1, 1, At, B1); PG8_BAR; PG8_SCHED;
        }
        if constexpr (ALIGN_EPI) { if (wr == 0) PG8_BAR; }
        E(acc, cur, wr, wc, fr, fq);
        if (!has_next) break;
#pragma unroll
        for (int a = 0; a < 2; ++a)
#pragma unroll
            for (int b = 0; b < 2; ++b)
#pragma unroll
                for (int m = 0; m < 4; ++m)
#pragma unroll
                    for (int n = 0; n < 2; ++n) acc[a][b][m][n] = (f32x4){0.f, 0.f, 0.f, 0.f};
        cur = nxt; cA = nA; cB = nB; ++ui;
        if constexpr (ALIGN_EPI) { if (wr == 1) PG8_BAR; }
    }
    PG8_WAIT_V(0);
    if constexpr (!ALIGN_EPI) { if (wr == 0) PG8_BAR; }
    PG8_BAR;
#undef PG8_SA
#undef PG8_SB
#undef PG8_GLDS
#undef PG8_STAGE_A
#undef PG8_STAGE_B
#undef PG8_LDA
#undef PG8_LDB
#undef PG8_MMA
#undef PG8_WAIT_V
#undef PG8_WAIT_L
#undef PG8_BAR
#undef PG8_SCHED
#undef PG8_GOFF
}

struct DenseSched {
    int nM, nN, nwg, G, c; const char* A; const char* Bt; size_t tstep;
    __device__ __forceinline__ void init(int M, int N, int K, int G_, int c_, const void* A_, const void* Bt_) { nM = M / BM; nN = N / BM; nwg = nM * nN; G = G_; c = c_; A = (const char*)A_; Bt = (const char*)Bt_; tstep = (size_t)BM * K * 2; }
    __device__ __forceinline__ bool next(int i, Unit& u) const {
        const long L = (long)i * G + c; if (L >= nwg) return false;
        int wgid = (int)L; { const int q = nwg / 8, r = nwg % 8, xcd = wgid % 8, off = wgid / 8; wgid = (xcd < r ? xcd * (q + 1) : r * (q + 1) + (xcd - r) * q) + off; }
        const int nig = 8 * nN, gid = wgid / nig, fm = gid * 8, gsz = (nM - fm) < 8 ? (nM - fm) : 8;
        u.pm = fm + ((wgid % nig) % gsz); u.pn = (wgid % nig) / gsz; u.e = 0; return true;
    }
    __device__ __forceinline__ const char* a_base(const Unit& u) const { return A + (size_t)u.pm * tstep; }
    __device__ __forceinline__ const char* b_base(const Unit& u) const { return Bt + (size_t)u.pn * tstep; }
    __device__ __forceinline__ unsigned grow(int, int) const { return 0u; }
};
struct MoeSched {
    const LAS int* ul; const LAS unsigned* tab; const char* A; const char* Bt; size_t tstepA, tstepB, estrideB;
    __device__ __forceinline__ bool next(int i, Unit& u) const {
        if (i >= 8) return false;
        const int ok = __builtin_amdgcn_readfirstlane(ul[i * 4 + 3]); if (!ok) return false;
        u.pm = __builtin_amdgcn_readfirstlane(ul[i * 4]); u.pn = __builtin_amdgcn_readfirstlane(ul[i * 4 + 1]); u.e = __builtin_amdgcn_readfirstlane(ul[i * 4 + 2]); return true;
    }
    __device__ __forceinline__ const char* a_base(const Unit& u) const { return A + (size_t)u.pm * tstepA; }
    __device__ __forceinline__ const char* b_base(const Unit& u) const { return Bt + (size_t)u.e * estrideB + (size_t)u.pn * tstepB; }
    __device__ __forceinline__ unsigned grow(int ui, int r) const { return tab[ui * 256 + r]; }
};
}


__device__ __forceinline__ int t5_bucket(int d) {
    if (d < 16) return d;
    return 16 + (d >= 22) + (d >= 30) + (d >= 40) + (d >= 54) + (d >= 73) + (d >= 99) + (d >= 134) + (d >= 182) + (d >= 246) + (d >= 332) + (d >= 450) + (d >= 609) + (d >= 825) + (d >= 1117) + (d >= 1513);
}
namespace att {
typedef __bf16 bf16x2_t __attribute__((ext_vector_type(2)));
typedef short s16x4 __attribute__((ext_vector_type(4)));
__device__ __forceinline__ unsigned cvtpk(float lo, float hi) { f32x2 v = {lo, hi}; bf16x2_t b = __builtin_convertvector(v, bf16x2_t); return __builtin_bit_cast(unsigned, b); }
__device__ __forceinline__ int crow(int r, int hi) { return (r & 3) + 8 * (r >> 2) + 4 * hi; }
__device__ __forceinline__ s16x4 vtr(LAS const unsigned char* p) { return __builtin_bit_cast(s16x4, __builtin_amdgcn_ds_read_tr16_b64_v4i16((LAS s16x4*)p)); }
constexpr int WL_BYTES = 16384;
constexpr int WL_V = 8192;
__device__ __forceinline__ void glds16(const void* gsrc, unsigned lds_dst) { unsigned keep;
    asm volatile("s_mov_b32 %0, m0\n\ts_mov_b32 m0, %2\n\ts_nop 0\n\tglobal_load_lds_dwordx4 %1, off\n\ts_mov_b32 m0, %0" : "=&s"(keep) : "v"(gsrc), "s"(lds_dst) : "memory"); }
__device__ __forceinline__ void dma_k(unsigned wl_addr, const bf16_t* kb, int t_first, int tstride, int lane) {
    const int r32 = lane & 31, hi = lane >> 5;
#pragma unroll
    for (int blk = 0; blk < 2; ++blk) { int tok = t_first + (r32 + 32 * blk) * tstride; tok = tok < 0 ? 0 : tok; const bf16_t* p = kb + (size_t)tok * NPROJ + 8 * hi;
#pragma unroll
        for (int d0 = 0; d0 < 4; ++d0) glds16(p + 16 * d0, (unsigned)__builtin_amdgcn_readfirstlane(wl_addr + (blk * 4 + d0) * 1024)); }
}
__device__ __forceinline__ void dma_v(unsigned wl_addr, const bf16_t* vb, int t_first, int tstride, int lane) {
#pragma unroll
    for (int kg = 0; kg < 4; ++kg) { int tok = t_first + (16 * kg + (lane >> 2)) * tstride; tok = tok < 0 ? 0 : tok; const bf16_t* p = vb + (size_t)tok * NPROJ + (lane & 3) * 8;
        glds16(p, (unsigned)__builtin_amdgcn_readfirstlane(wl_addr + WL_V + kg * 1024)); glds16(p + 32, (unsigned)__builtin_amdgcn_readfirstlane(wl_addr + WL_V + (4 + kg) * 1024)); }
}
__device__ __forceinline__ void read_k(bf16x8 (&kf)[8], LAS const unsigned char* wl, int lane) {
#pragma unroll
    for (int i = 0; i < 8; ++i) kf[i] = *(LAS const bf16x8*)(wl + i * 1024 + lane * 16);
    asm volatile("s_waitcnt lgkmcnt(0)" ::: "memory");
}
#define ATT_WAIT_V(n) asm volatile("s_waitcnt vmcnt(" #n ")" ::: "memory")
__device__ __forceinline__ void qk_tile(f32x16& p0, f32x16& p1, const bf16x8 (&kf)[8], const bf16x8 (&qf)[4]) {
    p0 = (f32x16){}; p1 = (f32x16){};
#pragma unroll
    for (int d0 = 0; d0 < 4; ++d0) { p0 = __builtin_amdgcn_mfma_f32_32x32x16_bf16(kf[d0], qf[d0], p0, 0, 0, 0); p1 = __builtin_amdgcn_mfma_f32_32x32x16_bf16(kf[4 + d0], qf[d0], p1, 0, 0, 0); }
}
__device__ __forceinline__ void pv_tile(f32x16 (&o)[2], const f32x16& p0, const f32x16& p1, LAS const unsigned char* wl, int lane) {
    const int hi = lane >> 5;
    u32x4 pw[4];
    pw[0] = (u32x4){cvtpk(p0[0], p0[1]), cvtpk(p0[2], p0[3]), cvtpk(p0[4], p0[5]), cvtpk(p0[6], p0[7])};
    pw[1] = (u32x4){cvtpk(p0[8], p0[9]), cvtpk(p0[10], p0[11]), cvtpk(p0[12], p0[13]), cvtpk(p0[14], p0[15])};
    pw[2] = (u32x4){cvtpk(p1[0], p1[1]), cvtpk(p1[2], p1[3]), cvtpk(p1[4], p1[5]), cvtpk(p1[6], p1[7])};
    pw[3] = (u32x4){cvtpk(p1[8], p1[9]), cvtpk(p1[10], p1[11]), cvtpk(p1[12], p1[13]), cvtpk(p1[14], p1[15])};
    LAS const unsigned char* vp = wl + WL_V + ((lane >> 4) & 1) * 32 + (lane & 3) * 8 + (4 * hi + ((lane & 15) >> 2)) * 64;
#pragma unroll
    for (int d0 = 0; d0 < 2; ++d0)
#pragma unroll
        for (int ks = 0; ks < 4; ++ks) {
            const s16x4 lo = vtr(vp + d0 * 4096 + ks * 1024), hh = vtr(vp + d0 * 4096 + ks * 1024 + 512);
            const bf16x8 vf = (bf16x8){lo[0], lo[1], lo[2], lo[3], hh[0], hh[1], hh[2], hh[3]};
            o[d0] = __builtin_amdgcn_mfma_f32_32x32x16_bf16(__builtin_bit_cast(bf16x8, pw[ks]), vf, o[d0], 0, 0, 0);
        }
}
__device__ __forceinline__ void epilogue(const f32x16 (&o)[2], float lq_val, LAS unsigned char* wl, LAS float* lq, const float* gain64, bf16_t* Yb, int ycol, int tok0, int tokstride, int lane) {
    const int r32 = lane & 31, hi = lane >> 5;
    LAS float* stg = (LAS float*)wl;
    ATT_WAIT_V(0);
#pragma unroll
    for (int d0 = 0; d0 < 2; ++d0)
#pragma unroll
        for (int r = 0; r < 16; ++r) stg[crow(r, hi) * 68 + 32 * d0 + r32] = o[d0][r];
    if (hi == 0) lq[r32] = lq_val;
    asm volatile("s_waitcnt lgkmcnt(0)" ::: "memory");
    const int row = lane >> 1, half = lane & 1;
    const float sc = lq[row];
    f32x4 v[8]; float ss = 0.f;
#pragma unroll
    for (int j = 0; j < 8; ++j) { v[j] = *(LAS const f32x4*)(wl + row * 272 + half * 128 + j * 16) * sc; ss += (v[j].x * v[j].x + v[j].y * v[j].y) + (v[j].z * v[j].z + v[j].w * v[j].w); }
    ss += __shfl_xor(ss, 1);
    const float rs = rsqrtf(ss * (1.f / 64.f) + 1e-6f);
    bf16_t* yp = Yb + (size_t)(tok0 + row * tokstride) * DM + ycol + half * 32;
    const float* gp = gain64 + half * 32;
#pragma unroll
    for (int j = 0; j < 4; ++j) {
        const f32x4 g0 = *(const f32x4*)(gp + 8 * j), g1 = *(const f32x4*)(gp + 8 * j + 4); const f32x4 a = v[2 * j] * rs * g0, c = v[2 * j + 1] * rs * g1;
        u32x4 w; w.x = cvtpk(a.x, a.y); w.y = cvtpk(a.z, a.w); w.z = cvtpk(c.x, c.y); w.w = cvtpk(c.z, c.w);
        *(u32x4*)(yp + 8 * j) = w;
    }
    asm volatile("s_waitcnt lgkmcnt(0)" ::: "memory");
}

__device__ __forceinline__ void sb_half(f32x16& p, float (&L)[16], int cbase, int lo_c, unsigned span) {
#pragma unroll
    for (int r = 0; r < 16; ++r) {
        const int c = cbase + (r & 3) + 8 * (r >> 2);
        const float z = ((unsigned)(c - lo_c) < span) ? p[r] : -1e30f;
        const float ez = __builtin_amdgcn_exp2f(-__builtin_fabsf(z)); const float lg = __builtin_amdgcn_logf(1.f + ez); const float sp = __builtin_fmaxf(z, 0.f) + lg;
        L[r] = -sp; p[r] = z - sp;
    }
}
__device__ __forceinline__ void sb_elem(f32x16& p0, f32x16& p1, float& R2, int hi, int lim, int lo) {
    float L0[16], L1[16];
    const int lo_c = lo - 4 * hi; const unsigned span = (unsigned)(lim - lo);
    sb_half(p0, L0, 0, lo_c, span); sb_half(p1, L1, 32, lo_c, span);
    float gs[8], ps[8], og[8];
#pragma unroll
    for (int k = 0; k < 4; ++k) { gs[k] = (L0[4 * k] + L0[4 * k + 1]) + (L0[4 * k + 2] + L0[4 * k + 3]); gs[4 + k] = (L1[4 * k] + L1[4 * k + 1]) + (L1[4 * k + 2] + L1[4 * k + 3]); }
#pragma unroll
    for (int k = 0; k < 8; ++k) { auto rr = __builtin_amdgcn_permlane32_swap(__float_as_uint(gs[k]), __float_as_uint(gs[k]), false, false);
        const float a = __uint_as_float(rr[0]), b = __uint_as_float(rr[1]); ps[k] = a + b; og[k] = hi ? 0.f : b; }
    float T[8]; float run = R2;
#pragma unroll
    for (int k = 7; k >= 0; --k) { T[k] = run + og[k]; run += ps[k]; }
    R2 = run;
#pragma unroll
    for (int k = 0; k < 4; ++k) {
        { float b = T[k]; p0[4 * k + 3] = __builtin_amdgcn_exp2f(p0[4 * k + 3] + b); b += L0[4 * k + 3]; p0[4 * k + 2] = __builtin_amdgcn_exp2f(p0[4 * k + 2] + b); b += L0[4 * k + 2];
          p0[4 * k + 1] = __builtin_amdgcn_exp2f(p0[4 * k + 1] + b); b += L0[4 * k + 1]; p0[4 * k] = __builtin_amdgcn_exp2f(p0[4 * k] + b); }
        { float b = T[4 + k]; p1[4 * k + 3] = __builtin_amdgcn_exp2f(p1[4 * k + 3] + b); b += L1[4 * k + 3]; p1[4 * k + 2] = __builtin_amdgcn_exp2f(p1[4 * k + 2] + b); b += L1[4 * k + 2];
          p1[4 * k + 1] = __builtin_amdgcn_exp2f(p1[4 * k + 1] + b); b += L1[4 * k + 1]; p1[4 * k] = __builtin_amdgcn_exp2f(p1[4 * k] + b); }
    }
}
__device__ __forceinline__ void sb_unit(const bf16_t* pb, int h, int q0, LAS unsigned char* wl, LAS float* wsc, const float* gain, bf16_t* Yb, int lane) {
    asm volatile("" : "+v"(lane));
    const int r32 = lane & 31, hi = lane >> 5;
    const unsigned wl_addr = (unsigned)(size_t)wl;
    bf16x8 qf[4];
    { const bf16_t* qp = pb + (size_t)(q0 + r32) * NPROJ + h * 64 + 8 * hi;
#pragma unroll
      for (int d0 = 0; d0 < 4; ++d0) qf[d0] = *(const bf16x8*)(qp + 16 * d0); }
    const bf16_t* kb = pb + 512 + h * 64; const bf16_t* vb = pb + 1024 + h * 64;
    const int nt = (q0 + 31) / 64 + 1;
    f32x16 o[2]; o[0] = (f32x16){}; o[1] = (f32x16){};
    float R2 = 0.f;
    asm volatile("s_waitcnt vmcnt(0)" ::: "memory");
    dma_k(wl_addr, kb, q0 - 32, 1, lane); dma_v(wl_addr, vb, q0 - 32, 1, lane);
    for (int j = 0; j < nt; ++j) {
        const int t_first = q0 - 32 - 64 * j; const bool more = (j + 1 < nt);
        ATT_WAIT_V(8);
        bf16x8 kf[8]; read_k(kf, wl, lane);
        if (more) dma_k(wl_addr, kb, t_first - 64, 1, lane);
        f32x16 p0, p1;
        qk_tile(p0, p1, kf, qf);
        sb_elem(p0, p1, R2, hi, (q0 + r32) - t_first, t_first < 0 ? -t_first : 0);
        if (more) ATT_WAIT_V(8); else ATT_WAIT_V(0);
        pv_tile(o, p0, p1, wl, lane);
        asm volatile("s_waitcnt lgkmcnt(0)" ::: "memory");
        if (__all(R2 < -150.f)) break;
        if (more) dma_v(wl_addr, vb, t_first - 64, 1, lane);
    }
    epilogue(o, 1.f, wl, wsc, gain + h * 64, Yb, h * 64, q0, 1, lane);
}
__device__ __forceinline__ void dil_elem(f32x16& p0, f32x16& p1, float& m, float& l, f32x16 (&o)[2], int sbl, int lo_c, int sh, LAS const float* tab, LAS float* wsf, int r32, int hi) {
    float tmax = -3e38f;
#pragma unroll
    for (int blk = 0; blk < 2; ++blk)
#pragma unroll
        for (int r = 0; r < 16; ++r) {
            const int c = 32 * blk + (r & 3) + 8 * (r >> 2); const int steps = sbl - c; const bool v = ((unsigned)steps <= 128u) && (c >= lo_c);
            const float bias = tab[v ? (steps << sh) : 0]; const float z = blk ? p1[r] : p0[r]; const float s = v ? z + bias : -3e38f;
            if (blk) p1[r] = s; else p0[r] = s; tmax = __builtin_fmaxf(tmax, s);
        }
    { auto rr = __builtin_amdgcn_permlane32_swap(__float_as_uint(tmax), __float_as_uint(tmax), false, false); tmax = __builtin_fmaxf(__uint_as_float(rr[0]), __uint_as_float(rr[1])); }
    const float mnew = __builtin_fmaxf(m, tmax);
    if (__any(mnew > m)) {
        const float f = __builtin_amdgcn_exp2f(m - mnew); l *= f;
        if (hi == 0) wsf[r32] = f;
        asm volatile("s_waitcnt lgkmcnt(0)" ::: "memory");
#pragma unroll
        for (int r = 0; r < 16; ++r) { const float fr = wsf[crow(r, hi)]; o[0][r] *= fr; o[1][r] *= fr; }
        asm volatile("s_waitcnt lgkmcnt(0)" ::: "memory");
    }
    m = mnew;
    float acc = 0.f;
#pragma unroll
    for (int r = 0; r < 16; ++r) { p0[r] = __builtin_amdgcn_exp2f(p0[r] - m); p1[r] = __builtin_amdgcn_exp2f(p1[r] - m); acc += p0[r] + p1[r]; }
    l += acc;
}
__device__ __forceinline__ void dil_params(int ti, int t0, int& t_first, int& tstride, int& sh, int& pk  , int& kc0, int& qs) {
    int j;
    if (ti < 10) { sh = 0; j = ti; } else if (ti < 14) { sh = 2; j = ti - 10; } else { sh = 4; j = ti - 14; }
    tstride = 1 << sh; qs = 16 >> sh;
    const int r = t0 & (tstride - 1), P0 = t0 >> sh;
    kc0 = P0 + qs * 31 - 63 - 64 * j; pk = P0 - kc0; t_first = r + tstride * kc0;
}
__device__ __forceinline__ void dil_unit(const bf16_t* pb, int h, int t0, LAS unsigned char* wl, LAS float* wsc, LAS const float* tab, const float* gain, bf16_t* Yb, int lane) {
    asm volatile("" : "+v"(lane));
    const int r32 = lane & 31, hi = lane >> 5;
    const unsigned wl_addr = (unsigned)(size_t)wl;
    bf16x8 qf[4];
    { const bf16_t* qp = pb + (size_t)(t0 + 16 * r32) * NPROJ + 1536 + h * 64 + 8 * hi;
#pragma unroll
      for (int d0 = 0; d0 < 4; ++d0) qf[d0] = *(const bf16x8*)(qp + 16 * d0); }
    const bf16_t* kb = pb + 2048 + h * 64; const bf16_t* vb = pb + 2560 + h * 64;
    f32x16 o[2]; o[0] = (f32x16){}; o[1] = (f32x16){};
    float m = -1e30f, l = 0.f;
    int t_first, tstride, sh, pk, kc0, qs;
    dil_params(0, t0, t_first, tstride, sh, pk, kc0, qs);
    asm volatile("s_waitcnt vmcnt(0)" ::: "memory");
    dma_k(wl_addr, kb, t_first, tstride, lane); dma_v(wl_addr, vb, t_first, tstride, lane);
    for (int ti = 0; ti < 17; ++ti) {
        const int c_sh = sh, c_pk = pk, c_kc0 = kc0, c_qs = qs; const bool more = (ti + 1 < 17);
        ATT_WAIT_V(8);
        bf16x8 kf[8]; read_k(kf, wl, lane);
        if (more) { dil_params(ti + 1, t0, t_first, tstride, sh, pk, kc0, qs); dma_k(wl_addr, kb, t_first, tstride, lane); }
        f32x16 p0, p1;
        qk_tile(p0, p1, kf, qf);
        dil_elem(p0, p1, m, l, o, c_pk + c_qs * r32 - 4 * hi, -c_kc0 - 4 * hi, c_sh, tab, wsc + 32, r32, hi);
        if (more) ATT_WAIT_V(8); else ATT_WAIT_V(0);
        pv_tile(o, p0, p1, wl, lane);
        asm volatile("s_waitcnt lgkmcnt(0)" ::: "memory");
        if (more) dma_v(wl_addr, vb, t_first, tstride, lane);
    }
    { auto rr = __builtin_amdgcn_permlane32_swap(__float_as_uint(l), __float_as_uint(l), false, false); l = __uint_as_float(rr[0]) + __uint_as_float(rr[1]); }
    epilogue(o, 1.f / l, wl, wsc, gain + h * 64, Yb, 512 + h * 64, t0, 16, lane);
}
}

#define XB_TMO      128
#define XB_XCNT(j)  (256  + 64 * (j))
#define XB_XSUB(j)  (1280 + 64 * (j))
#define XB_XGEN(j)  (2304 + 64 * (j))
#define XB_TOP      3328
#define XB_TOPGEN   3392
#define XCD_BAR_WORDS 3456
#define XB_SPIN_CAP (1u << 18)
__device__ __forceinline__ unsigned xb_ld(unsigned* p)              { return __hip_atomic_load(p, __ATOMIC_RELAXED, __HIP_MEMORY_SCOPE_AGENT); }
__device__ __forceinline__ unsigned xb_add(unsigned* p, unsigned v) { return __hip_atomic_fetch_add(p, v, __ATOMIC_RELAXED, __HIP_MEMORY_SCOPE_AGENT); }
__device__ __forceinline__ unsigned xb_xcc_id() { return (unsigned)__builtin_amdgcn_s_getreg((3 << 11) | 20) & 0xFu; }
#define XB_SPIN(cond, bar) do { unsigned _sp = 0; while (cond) { __builtin_amdgcn_s_sleep(1); \
    if ((++_sp & 255u) == 0u) { if (xb_ld(&(bar)[XB_TMO])) break; if (_sp > XB_SPIN_CAP) { atomicAdd(&(bar)[XB_TMO], 1u); break; } } } } while (0)
struct XcdBarrier { unsigned* bar; unsigned x; volatile LAS unsigned* st; };
__device__ __forceinline__ XcdBarrier xcd_barrier_post(unsigned* bar, volatile LAS unsigned* st) {
    XcdBarrier b; b.bar = bar; b.x = xb_xcc_id(); b.st = st;
    if (threadIdx.x == 0) (void)xb_add(&bar[XB_XCNT(b.x)], 1u);
    return b;
}
__device__ __forceinline__ void xcd_barrier_complete(unsigned* bar, unsigned x, unsigned& nloc, unsigned& nx) {
    const unsigned G = gridDim.x * gridDim.y * gridDim.z;
    unsigned sum, cnt, mine, sp = 0u;
    for (;;) {
        sum = 0u; cnt = 0u; mine = 0u;
#pragma unroll
        for (unsigned j = 0; j < 16; ++j) { const unsigned c = xb_ld(&bar[XB_XCNT(j)]); sum += c; cnt += (c > 0u) ? 1u : 0u; mine = (j == x) ? c : mine; }
        if (sum == G) break;
        __builtin_amdgcn_s_sleep(1);
        if ((++sp & 255u) == 0u) { if (xb_ld(&bar[XB_TMO])) break; if (sp > XB_SPIN_CAP) { atomicAdd(&bar[XB_TMO], 1u); break; } }
    }
    nloc = mine > 0u ? mine : 1u; nx = cnt > 0u ? cnt : 1u;
}
__device__ __forceinline__ void xcd_barrier(const XcdBarrier& b) {
    asm volatile("s_waitcnt vmcnt(0)" ::: "memory");
    __syncthreads();
    if (threadIdx.x == 0) {
        unsigned* bar = b.bar;
        __builtin_amdgcn_s_waitcnt(0);
        unsigned nloc = b.st[0], nx = b.st[1];
        if (nloc == 0u) { xcd_barrier_complete(bar, b.x, nloc, nx); b.st[0] = nloc; b.st[1] = nx; }
        const unsigned old = xb_add(&bar[XB_XSUB(b.x)], 1u);
        const unsigned gen = old / nloc;
        if (old + 1u == (gen + 1u) * nloc) {
            __builtin_amdgcn_fence(__ATOMIC_RELEASE, "agent");
            asm volatile("s_waitcnt vmcnt(0)" ::: "memory");
            const unsigned og = xb_add(&bar[XB_TOP], 1u);
            const unsigned tg = og / nx;
            if (og + 1u == (tg + 1u) * nx) xb_add(&bar[XB_TOPGEN], 1u);
            else XB_SPIN(xb_ld(&bar[XB_TOPGEN]) == tg, bar);
            __builtin_amdgcn_fence(__ATOMIC_ACQUIRE, "agent");
            xb_add(&bar[XB_XGEN(b.x)], 1u);
            asm volatile("s_waitcnt vmcnt(0)" ::: "memory");
        } else {
            XB_SPIN(xb_ld(&bar[XB_XGEN(b.x)]) == gen, bar);
            __builtin_amdgcn_fence(__ATOMIC_ACQUIRE, "agent");
            asm volatile("s_waitcnt vmcnt(0)" ::: "memory");
        }
    }
    __syncthreads();
}

constexpr int NWAVES = 8;
constexpr int RING_BYTES = 131072;
constexpr int TAB_OFF = RING_BYTES;
constexpr int PB_OFF = TAB_OFF + 8192;
constexpr int MISC_OFF = PB_OFF + 512;
constexpr int WSC_OFF = MISC_OFF + 256;
constexpr int LDS_BYTES = 147456;
static_assert(WSC_OFF + 2048 <= LDS_BYTES, "LDS map");
constexpr int PH_PER_LAYER = 8, N_PHASES = DEPTH * PH_PER_LAYER;
enum { PH_W = 0, PH_QKV = 1, PH_ATT = 2, PH_OUT = 3, PH_LNR = 4, PH_MOE1 = 5, PH_MOE2 = 6, PH_COMB = 7 };

struct Args { const float* in[15]; float* out; unsigned char* ws; int ph_lo, ph_hi; };

__device__ __forceinline__ float wave_sum(float v) {
#pragma unroll
    for (int o = 1; o < 64; o <<= 1) v += __shfl_xor(v, o);
    return v;
}
__device__ __forceinline__ void transpose_item(const float* W, int K, int N, bf16_t* WT, int row_off, LAS float* scr, int kb, int nb, int lane) {
    const int k0 = 64 * kb, n0 = 32 * nb;
#pragma unroll 8
    for (int i = 0; i < 32; ++i) { const int kk = 2 * i + (lane >> 5); scr[kk * 33 + (lane & 31)] = W[(size_t)(k0 + kk) * N + n0 + (lane & 31)]; }
    asm volatile("s_waitcnt lgkmcnt(0)" ::: "memory");
    const int c = lane & 7;
#pragma unroll
    for (int j = 0; j < 4; ++j) { const int n = (lane >> 3) + 8 * j; const LAS float* s = scr + (8 * c) * 33 + n;
        u32x4 o; o.x = pk2(s[0 * 33], s[1 * 33]); o.y = pk2(s[2 * 33], s[3 * 33]); o.z = pk2(s[4 * 33], s[5 * 33]); o.w = pk2(s[6 * 33], s[7 * 33]);
        *(u32x4*)(WT + (size_t)(row_off + n0 + n) * K + k0 + 8 * c) = o; }
    asm volatile("s_waitcnt lgkmcnt(0)" ::: "memory");
}

__global__ void __launch_bounds__(NWAVES * 64, 2) mk(Args args) {
    extern __shared__ __attribute__((aligned(16))) unsigned char lds_raw[];
    LAS unsigned char* lds = (LAS unsigned char*)lds_raw;
    volatile LAS unsigned* MISC = (volatile LAS unsigned*)(lds + MISC_OFF);
    const int tid = threadIdx.x, lane = tid & 63, wave = __builtin_amdgcn_readfirstlane(tid >> 6);
    const int G = gridDim.x; const int bx = blockIdx.x; const int vcu = (G % 8 == 0) ? (bx % 8) * (G / 8) + bx / 8 : bx;
    unsigned char* ws = args.ws;
    unsigned* ctl = (unsigned*)(ws + WS_CTL);
    for (int u = tid; u < 32; u += NWAVES * 64) MISC[u] = 0u;
    __syncthreads();
    const bool multi = (args.ph_hi - args.ph_lo) > 1;
    XcdBarrier bar; bar.bar = ctl + CW_BAR; bar.x = 0; bar.st = nullptr;
    if (multi) bar = xcd_barrier_post(ctl + CW_BAR, MISC + 8);

    const float* x_in = args.in[0]; const float* w_in = args.in[1]; const float* w_out = args.in[4];
    const float* w_gate = args.in[12]; const float* w_up = args.in[13]; const float* w_down = args.in[14];
    bf16_t* Win_t = (bf16_t*)(ws + WS_WIN); bf16_t* Wout_t = (bf16_t*)(ws + WS_WOUT); bf16_t* Wgu_t = (bf16_t*)(ws + WS_WGU); bf16_t* Wd_t = (bf16_t*)(ws + WS_WD);
    bf16_t* XB = (bf16_t*)(ws + WS_XB); float* XC = (float*)(ws + WS_XC); bf16_t* PROJ = (bf16_t*)(ws + WS_PROJ); bf16_t* HB = (bf16_t*)(ws + WS_H);
    bf16_t* Y = (bf16_t*)(ws + WS_Y); float* T = (float*)(ws + WS_T); bf16_t* YP = (bf16_t*)(ws + WS_YP); bf16_t* X1B = (bf16_t*)(ws + WS_X1B);
    const int* perm = (const int*)(ws + WS_PERM);

#define IN(k) (args.ph_lo <= (k) && (k) < args.ph_hi)
#define SEAM(k) do { if (IN(k) && IN((k) + 1)) xcd_barrier(bar); } while (0)
    for (int l = 0; l < DEPTH; ++l) {
        const int pbase = l * PH_PER_LAYER;
        const float* xres = (l == 0) ? x_in : XC;
        if (IN(pbase + PH_W)) {
            int tl = threadIdx.x; asm volatile("" : "+v"(tl)); const int lane = tl & 63, wave = __builtin_amdgcn_readfirstlane(tl >> 6);
            LAS float* scr = (LAS float*)(lds + wave * 16384);
            const int gw = vcu * NWAVES + wave, NGW = G * NWAVES;
            constexpr int I_IN = 16 * 96, I_SQ = 16 * 32, NITEMS = I_IN + I_SQ + 48 * I_SQ;
            for (int it = gw; it < NITEMS; it += NGW) {
                int r = it;
                if (r < I_IN) { transpose_item(w_in + (size_t)l * DM * NPROJ, DM, NPROJ, Win_t, 0, scr, r / 96, r % 96, lane); continue; } r -= I_IN;
                if (r < I_SQ) { transpose_item(w_out + (size_t)l * DM * DM, DM, DM, Wout_t, 0, scr, r / 32, r % 32, lane); continue; } r -= I_SQ;
                const int mtx = r / I_SQ, e = mtx / 3, kind = mtx % 3, rr = r % I_SQ, kb = rr / 32, nb = rr % 32;
                const size_t eoff = ((size_t)l * NEXP + e) * DM * FF;
                if (kind == 2) transpose_item(w_down + eoff, FF, DM, Wd_t + (size_t)e * DM * FF, 0, scr, kb, nb, lane);
                else transpose_item((kind == 0 ? w_gate : w_up) + eoff, DM, FF, Wgu_t + (size_t)e * 2 * FF * DM, (nb >> 2) * 128 + kind * 128, scr, kb, nb, lane);
            }
            if (l == 0) for (int m = gw; m < NTOK; m += NGW) {
                const f32x4* xr = (const f32x4*)(x_in + (size_t)m * DM) + lane; unsigned long long* o8 = (unsigned long long*)(XB + (size_t)m * DM) + lane;
#pragma unroll
                for (int j = 0; j < 4; ++j) { const f32x4 v = xr[64 * j]; o8[64 * j] = (unsigned long long)pk2(v.x, v.y) | ((unsigned long long)pk2(v.z, v.w) << 32); }
            }
            __syncthreads();
        }
        SEAM(pbase + PH_W);
        if (IN(pbase + PH_QKV)) {
            pg8::DenseSched S; S.init(NTOK, NPROJ, DM, G, bx, XB, Win_t);
            pg8::EpiProj E{PROJ};
            pg8::gemm_phase<pg8::EpiProj, pg8::DenseSched, false, true>(lds, DM, S, E);
        }
        SEAM(pbase + PH_QKV);
        if (IN(pbase + PH_ATT)) {
            int tl = threadIdx.x; asm volatile("" : "+v"(tl)); const int lane = tl & 63, wave = __builtin_amdgcn_readfirstlane(tl >> 6);
            LAS unsigned char* wl = lds + wave * att::WL_BYTES;
            LAS float* tab = (LAS float*)(lds + TAB_OFF);
            LAS float* wsc = (LAS float*)(lds + WSC_OFF + wave * 256);
            const float* g_sb = args.in[2] + l * 512; const float* g_dil = args.in[3] + l * 512; const float* rel_bias = args.in[9];
            for (int wu = vcu; wu < 256; wu += G) {
                const int b = wu >> 7, h = (wu >> 4) & 7, blk = wu & 15;
                const bf16_t* pb = PROJ + (size_t)b * SEQ * NPROJ; bf16_t* Yb = Y + (size_t)b * SEQ * DM;
                __syncthreads();
                for (int d = tl; d <= 2048; d += NWAVES * 64) tab[d] = rel_bias[t5_bucket(d) * 8 + h] * LOG2E;
                __syncthreads();
                for (int rd = 0; rd < 2; ++rd) att::sb_unit(pb, h, blk * 512 + (rd * 8 + wave) * 32, wl, wsc, g_sb, Yb, lane);
                for (int rd = 0; rd < 2; ++rd) att::dil_unit(pb, h, blk * 512 + rd * 8 + wave, wl, wsc, tab, g_dil, Yb, lane);
            }
            __syncthreads();
        }
        SEAM(pbase + PH_ATT);
        if (IN(pbase + PH_OUT)) {
            pg8::DenseSched S; S.init(NTOK, DM, DM, G, bx, Y, Wout_t);
            pg8::EpiRes E{xres, T};
            pg8::gemm_phase<pg8::EpiRes, pg8::DenseSched, false, false>(lds, DM, S, E);
        }
        SEAM(pbase + PH_OUT);
        if (IN(pbase + PH_LNR)) {
            int tl = threadIdx.x; asm volatile("" : "+v"(tl)); const int lane = tl & 63, wave = __builtin_amdgcn_readfirstlane(tl >> 6);
            LAS float* wrt = (LAS float*)lds;
            LAS int* re = (LAS int*)(lds + 65536);
            LAS float* rg = (LAS float*)(lds + 65536 + 512);
            LAS int* sbase = (LAS int*)(lds + 65536 + 1024);
            const float* w_router = args.in[10]; const float* b_router = args.in[11];
            const float* lg = args.in[5] + l * DM; const float* lb = args.in[6] + l * DM;
            float* X1 = (float*)(ws + WS_X1); int* cnt = (int*)(ctl + CW_CNT + l * 16); int* permw = (int*)(ws + WS_PERM); TokInfo* info = (TokInfo*)(ws + WS_INFO);
            __syncthreads();
            for (int i = tl; i < 16 * DM; i += NWAVES * 64) wrt[(i & 15) * DM + (i >> 4)] = w_router[i];
            __syncthreads();
            for (int wu = vcu; wu < NTOK / 64; wu += G) {
                for (int i = 0; i < 8; ++i) {
                    const int lt = wave * 8 + i, tok = wu * 64 + lt;
                    const f32x4* xr = (const f32x4*)(T + (size_t)tok * DM) + lane;
                    f32x4 v[4]; float s = 0.f;
#pragma unroll
                    for (int j = 0; j < 4; ++j) { v[j] = xr[64 * j]; s += (v[j].x + v[j].y) + (v[j].z + v[j].w); }
                    const float mean = wave_sum(s) * (1.f / DM); float s2 = 0.f;
#pragma unroll
                    for (int j = 0; j < 4; ++j) { v[j] = v[j] - mean; s2 += (v[j].x * v[j].x + v[j].y * v[j].y) + (v[j].z * v[j].z + v[j].w * v[j].w); }
                    const float rstd = rsqrtf(wave_sum(s2) * (1.f / DM) + LN_EPS);
                    f32x4* o4 = (f32x4*)(X1 + (size_t)tok * DM) + lane; unsigned long long* o8 = (unsigned long long*)(X1B + (size_t)tok * DM) + lane;
#pragma unroll
                    for (int j = 0; j < 4; ++j) { const f32x4 gv = ((const f32x4*)lg)[lane + 64 * j], bv = ((const f32x4*)lb)[lane + 64 * j];
                        v[j] = v[j] * rstd * gv + bv; o4[64 * j] = v[j]; o8[64 * j] = (unsigned long long)pk2(v[j].x, v[j].y) | ((unsigned long long)pk2(v[j].z, v[j].w) << 32); }
                    float acc[16];
#pragma unroll
                    for (int e = 0; e < 16; ++e) { float a = 0.f;
#pragma unroll
                        for (int j = 0; j < 4; ++j) { const f32x4 w = *(const LAS f32x4*)(wrt + e * DM + 256 * j + 4 * lane); a += (v[j].x * w.x + v[j].y * w.y) + (v[j].z * w.z + v[j].w * w.w); }
                        acc[e] = a; }
                    { const bool up = (lane & 32) != 0;
#pragma unroll
                      for (int k = 0; k < 8; ++k) { const float snd = up ? acc[k] : acc[k + 8]; const float kp = up ? acc[k + 8] : acc[k]; acc[k] = kp + __shfl_xor(snd, 32); } }
                    { const bool up = (lane & 16) != 0;
#pragma unroll
                      for (int k = 0; k < 4; ++k) { const float snd = up ? acc[k] : acc[k + 4]; const float kp = up ? acc[k + 4] : acc[k]; acc[k] = kp + __shfl_xor(snd, 16); } }
                    { const bool up = (lane & 8) != 0;
#pragma unroll
                      for (int k = 0; k < 2; ++k) { const float snd = up ? acc[k] : acc[k + 2]; const float kp = up ? acc[k + 2] : acc[k]; acc[k] = kp + __shfl_xor(snd, 8); } }
                    { const bool up = (lane & 4) != 0; const float snd = up ? acc[0] : acc[1]; const float kp = up ? acc[1] : acc[0]; acc[0] = kp + __shfl_xor(snd, 4); }
                    float tot = acc[0]; tot += __shfl_xor(tot, 2); tot += __shfl_xor(tot, 1);
                    float lgt[16]; float mx = -1e30f;
#pragma unroll
                    for (int e = 0; e < 16; ++e) { const int src = ((e >> 3) & 1) * 32 + ((e >> 2) & 1) * 16 + ((e >> 1) & 1) * 8 + (e & 1) * 4;
                        lgt[e] = __uint_as_float(__builtin_amdgcn_readlane(__float_as_uint(tot), src)) + b_router[e]; mx = fmaxf(mx, lgt[e]); }
                    float best = -1.f; int be1 = 0, be2 = 0; float bv1 = 0.f, bv2 = 0.f;
#pragma unroll
                    for (int gI = 0; gI < 4; ++gI) {
                        float v1 = -1.f, v2 = -1.f; int i1 = 0, i2 = 0;
#pragma unroll
                        for (int j = 0; j < 4; ++j) { const float pv = expf(lgt[gI * 4 + j] - mx);
                            if (pv > v1) { v2 = v1; i2 = i1; v1 = pv; i1 = j; } else if (pv > v2) { v2 = pv; i2 = j; } }
                        const float sm = v1 + v2;
                        if (sm > best) { best = sm; be1 = gI * 4 + i1; be2 = gI * 4 + i2; bv1 = v1; bv2 = v2; }
                    }
                    if (lane == 0) { re[lt * 2] = be1; re[lt * 2 + 1] = be2; rg[lt * 2] = bv1 / (bv1 + bv2); rg[lt * 2 + 1] = bv2 / (bv1 + bv2); }
                }
                __syncthreads();
                if (wave == 0) {
                    if (lane < 16) { int n = 0; for (int q = 0; q < 128; ++q) n += (re[q] == lane) ? 1 : 0; sbase[lane] = n ? (int)__hip_atomic_fetch_add(cnt + lane, n, __ATOMIC_RELAXED, __HIP_MEMORY_SCOPE_AGENT) : 0; }
                    asm volatile("s_waitcnt vmcnt(0) lgkmcnt(0)" ::: "memory");
                    const int e1 = re[lane * 2], e2 = re[lane * 2 + 1]; int r1 = 0, r2 = 0;
                    for (int q = 0; q < lane; ++q) { const int a = re[q * 2], b2 = re[q * 2 + 1]; r1 += (a == e1) + (b2 == e1); r2 += (a == e2) + (b2 == e2); }
                    const int s1 = sbase[e1] + r1, sl2 = sbase[e2] + r2; const int tok = wu * 64 + lane;
                    permw[e1 * NTOK + s1] = tok; permw[e2 * NTOK + sl2] = tok;
                    TokInfo ti; ti.e1 = e1; ti.e2 = e2; ti.s1 = s1; ti.s2 = sl2; ti.g1 = rg[lane * 2]; ti.g2 = rg[lane * 2 + 1]; ti.pad0 = 0; ti.pad1 = 0;
                    info[tok] = ti;
                }
                __syncthreads();
            }
        }
        SEAM(pbase + PH_LNR);
        if (IN(pbase + PH_MOE1) || IN(pbase + PH_MOE2)) {
            LAS int* pb = (LAS int*)(lds + PB_OFF); LAS int* ul = pb + 32; LAS unsigned* tab = (LAS unsigned*)(lds + TAB_OFF);
            const int* cnt = (const int*)(ctl + CW_CNT + l * 16);
            __syncthreads();
            if (tid == 0) { int sacc = 0; for (int e = 0; e < 16; ++e) { pb[e] = sacc; sacc += (cnt[e] + 255) >> 8; } pb[16] = sacc; }
            __syncthreads();
#define MOE_ULIST(NT) do { if (tid < 8) { const int L = tid * G + vcu; const int okv = L < pb[16] * (NT); const int p = okv ? L / (NT) : 0; int e = 0; \
                for (int j = 1; j < 16; ++j) e += (pb[j] <= p) ? 1 : 0; ul[tid * 4] = p; ul[tid * 4 + 1] = L % (NT); ul[tid * 4 + 2] = e; ul[tid * 4 + 3] = okv; } __syncthreads(); } while (0)
            if (IN(pbase + PH_MOE1)) {
                MOE_ULIST(8);
#pragma unroll 1
                for (int i = 0; i < 8; ++i) {
                    if (ul[i * 4 + 3] && tid < 256) { const int e = ul[i * 4 + 2]; const int slot = (ul[i * 4] - pb[e]) * 256 + tid; const int c = cnt[e]; const int tok = perm[e * NTOK + (slot < c ? slot : 0)]; tab[i * 256 + tid] = (unsigned)tok * (unsigned)(DM * 2); }
                }
                __syncthreads();
                pg8::MoeSched S{ul, tab, (const char*)X1B, (const char*)Wgu_t, 0, (size_t)256 * DM * 2, (size_t)2 * FF * DM * 2};
                pg8::EpiSwiGLU E{HB};
                pg8::gemm_phase<pg8::EpiSwiGLU, pg8::MoeSched, true, true>(lds, DM, S, E);
            }
            SEAM(pbase + PH_MOE1);
            if (IN(pbase + PH_MOE2)) {
                MOE_ULIST(4);
                pg8::MoeSched S{ul, tab, (const char*)HB, (const char*)Wd_t, (size_t)256 * FF * 2, (size_t)256 * FF * 2, (size_t)DM * FF * 2};
                pg8::EpiPlain E{YP, DM};
                pg8::gemm_phase<pg8::EpiPlain, pg8::MoeSched, false, true>(lds, FF, S, E);
            }
#undef MOE_ULIST
        }
        SEAM(pbase + PH_MOE2);
        if (IN(pbase + PH_COMB)) {
            int tl = threadIdx.x; asm volatile("" : "+v"(tl)); const int lane = tl & 63, wave = __builtin_amdgcn_readfirstlane(tl >> 6);
            LAS int* pb = (LAS int*)(lds + PB_OFF);
            const int* cnt = (const int*)(ctl + CW_CNT + l * 16);
            __syncthreads();
            if (tl == 0) { int sacc = 0; for (int e = 0; e < 16; ++e) { pb[e] = sacc; sacc += (cnt[e] + 255) >> 8; } pb[16] = sacc; }
            __syncthreads();
            const float* X1 = (const float*)(ws + WS_X1); const TokInfo* info = (const TokInfo*)(ws + WS_INFO);
            const float* lg = args.in[7] + l * DM; const float* lb = args.in[8] + l * DM;
            const bool lastl = (l == DEPTH - 1);
            const int gw = vcu * NWAVES + wave, NGW = G * NWAVES;
            for (int tok = gw; tok < NTOK; tok += NGW) {
                const TokInfo ti = info[tok];
                const f32x4* xr = (const f32x4*)(X1 + (size_t)tok * DM) + lane;
                const u32x2* y1 = (const u32x2*)(YP + (size_t)(pb[ti.e1] * 256 + ti.s1) * DM) + lane;
                const u32x2* y2 = (const u32x2*)(YP + (size_t)(pb[ti.e2] * 256 + ti.s2) * DM) + lane;
                f32x4 v[4]; float s = 0.f;
#pragma unroll
                for (int j = 0; j < 4; ++j) { const f32x4 x = xr[64 * j]; const u32x2 a = y1[64 * j], c = y2[64 * j];
                    const f32x4 ya = (f32x4){__uint_as_float(a.x << 16), __uint_as_float(a.x & 0xffff0000u), __uint_as_float(a.y << 16), __uint_as_float(a.y & 0xffff0000u)};
                    const f32x4 yc = (f32x4){__uint_as_float(c.x << 16), __uint_as_float(c.x & 0xffff0000u), __uint_as_float(c.y << 16), __uint_as_float(c.y & 0xffff0000u)};
                    v[j] = x * ALPHA + (ya * ti.g1 + yc * ti.g2); s += (v[j].x + v[j].y) + (v[j].z + v[j].w); }
                const float mean = wave_sum(s) * (1.f / DM); float s2 = 0.f;
#pragma unroll
                for (int j = 0; j < 4; ++j) { v[j] = v[j] - mean; s2 += (v[j].x * v[j].x + v[j].y * v[j].y) + (v[j].z * v[j].z + v[j].w * v[j].w); }
                const float rstd = rsqrtf(wave_sum(s2) * (1.f / DM) + LN_EPS);
                f32x4* o4 = (f32x4*)((lastl ? args.out : XC) + (size_t)tok * DM) + lane; unsigned long long* o8 = (unsigned long long*)(XB + (size_t)tok * DM) + lane;
#pragma unroll
                for (int j = 0; j < 4; ++j) { const f32x4 gv = ((const f32x4*)lg)[lane + 64 * j], bv = ((const f32x4*)lb)[lane + 64 * j];
                    const f32x4 y = v[j] * rstd * gv + bv; o4[64 * j] = y;
                    if (!lastl) o8[64 * j] = (unsigned long long)pk2(y.x, y.y) | ((unsigned long long)pk2(y.z, y.w) << 32); }
            }
        }
        SEAM(pbase + PH_COMB);
    }
#undef IN
#undef SEAM
}

struct NGemm { const bf16_t* A; int lda; const int* rowmap; const int* cnt; const int* coff; const float* B; const float* B2; long bstride; int ldb; void* C; int ldc; int M; int K; const float* R; int pad; };
template <int MODE>
__global__ void __launch_bounds__(256) ngemm(NGemm g) {
    __shared__ float As[16][68];
    __shared__ float Bs[16][64];
    __shared__ float Bs2[MODE == 2 ? 16 : 1][64];
    const int z = blockIdx.z, tid = threadIdx.x;
    const int M = g.cnt ? g.cnt[z] : g.M;
    const int r0 = blockIdx.y * 64, n0 = blockIdx.x * 64;
    if (r0 >= M) return;
    const int cbase = g.coff ? g.coff[z] : 0;
    const float* B = g.B + (long)z * g.bstride;
    const float* B2 = MODE == 2 ? g.B2 + (long)z * g.bstride : nullptr;
    const int lr = tid >> 2, lk = (tid & 3) * 4;
    int rr = r0 + lr; if (rr >= M) rr = M - 1;
    const long arow = g.rowmap ? (long)g.rowmap[(long)z * NTOK + rr] : (long)(cbase + rr);
    const bf16_t* ap = g.A + arow * g.lda + lk;
    const int bk = tid >> 4, bn = (tid & 15) * 4;
    const int tx = tid & 15, ty = tid >> 4;
    float acc[4][4], acc2[4][4];
#pragma unroll
    for (int i = 0; i < 4; ++i)
#pragma unroll
        for (int j = 0; j < 4; ++j) { acc[i][j] = 0.f; acc2[i][j] = 0.f; }
    for (int k0 = 0; k0 < g.K; k0 += 16) {
        const u32x2 av = *(const u32x2*)(ap + k0);
        const float4 bv = *(const float4*)(B + (long)(k0 + bk) * g.ldb + n0 + bn);
        float4 bv2 = make_float4(0.f, 0.f, 0.f, 0.f);
        if (MODE == 2) bv2 = *(const float4*)(B2 + (long)(k0 + bk) * g.ldb + n0 + bn);
        __syncthreads();
        As[lk + 0][lr] = __uint_as_float(av.x << 16); As[lk + 1][lr] = __uint_as_float(av.x & 0xffff0000u); As[lk + 2][lr] = __uint_as_float(av.y << 16); As[lk + 3][lr] = __uint_as_float(av.y & 0xffff0000u);
        *(float4*)&Bs[bk][bn] = bv;
        if (MODE == 2) *(float4*)&Bs2[bk][bn] = bv2;
        __syncthreads();
#pragma unroll
        for (int k = 0; k < 16; ++k) {
            const float4 a = *(const float4*)&As[k][ty * 4];
            const float4 b = *(const float4*)&Bs[k][tx * 4];
            const float aa[4] = {a.x, a.y, a.z, a.w}, bb[4] = {b.x, b.y, b.z, b.w};
#pragma unroll
            for (int i = 0; i < 4; ++i)
#pragma unroll
                for (int j = 0; j < 4; ++j) acc[i][j] += aa[i] * bb[j];
            if (MODE == 2) {
                const float4 b2 = *(const float4*)&Bs2[k][tx * 4];
                const float bb2[4] = {b2.x, b2.y, b2.z, b2.w};
#pragma unroll
                for (int i = 0; i < 4; ++i)
#pragma unroll
                    for (int j = 0; j < 4; ++j) acc2[i][j] += aa[i] * bb2[j];
            }
        }
    }
#pragma unroll
    for (int i = 0; i < 4; ++i) {
        const int r = r0 + ty * 4 + i;
        if (r >= M) continue;
        float o[4];
        const int col = n0 + tx * 4;
#pragma unroll
        for (int j = 0; j < 4; ++j) {
            float v = acc[i][j];
            if (MODE == 0) { const int ct = col >> 8; if (ct < 2 || ct == 6 || ct == 7) v *= QSCALE; }
            if (MODE == 2) { const float gte = v; v = gte / (1.f + expf(-gte)) * acc2[i][j]; }
            o[j] = v;
        }
        const long crow = cbase + r;
        if (MODE == 1) {
            const float4 rv = *(const float4*)(g.R + crow * DM + col);
            *(float4*)((float*)g.C + crow * g.ldc + col) = make_float4(o[0] + ALPHA * rv.x, o[1] + ALPHA * rv.y, o[2] + ALPHA * rv.z, o[3] + ALPHA * rv.w);
        } else {
            u32x2 w; w.x = pk2(o[0], o[1]); w.y = pk2(o[2], o[3]);
            *(u32x2*)((bf16_t*)g.C + crow * g.ldc + col) = w;
        }
    }
}

__device__ __forceinline__ void ld8bf(const bf16_t* p, float* o) { const u32x4 v = *(const u32x4*)p;
    o[0] = __uint_as_float(v.x << 16); o[1] = __uint_as_float(v.x & 0xffff0000u); o[2] = __uint_as_float(v.y << 16); o[3] = __uint_as_float(v.y & 0xffff0000u);
    o[4] = __uint_as_float(v.z << 16); o[5] = __uint_as_float(v.z & 0xffff0000u); o[6] = __uint_as_float(v.w << 16); o[7] = __uint_as_float(v.w & 0xffff0000u); }

__global__ void __launch_bounds__(64) sb_attn_naive(const bf16_t* __restrict__ proj, const float* __restrict__ gain, bf16_t* __restrict__ Y) {
    __shared__ float Ks[64][64];
    __shared__ float Vs[64][64];
    const int lane = threadIdx.x, qb = blockIdx.x, h = blockIdx.y, b = blockIdx.z;
    const int t = qb * 64 + lane;
    const bf16_t* base = proj + (long)b * SEQ * NPROJ;
    float q[64], o[64];
    {
        const bf16_t* qp = base + (long)t * NPROJ + h * 64;
#pragma unroll
        for (int d = 0; d < 64; d += 8) { ld8bf(qp + d, q + d); }
#pragma unroll
        for (int d = 0; d < 64; ++d) { q[d] *= LN2; o[d] = 0.f; }
    }
    float R = 0.f;
    for (int kt = qb; kt >= 0; --kt) {
        __syncthreads();
#pragma unroll
        for (int it = 0; it < 8; ++it) {
            const int row = it * 8 + (lane >> 3), c8 = (lane & 7) * 8;
            const bf16_t* kp = base + (long)(kt * 64 + row) * NPROJ + 512 + h * 64 + c8;
            float tmp[8]; ld8bf(kp, tmp);
#pragma unroll
            for (int j = 0; j < 8; ++j) Ks[row][c8 + j] = tmp[j];
            ld8bf(kp + 512, tmp);
#pragma unroll
            for (int j = 0; j < 8; ++j) Vs[row][c8 + j] = tmp[j];
        }
        __syncthreads();
        for (int j = 63; j >= 0; --j) {
            const int kj = kt * 64 + j;
            float z = 0.f;
#pragma unroll
            for (int d = 0; d < 64; d += 4) { const float4 kv = *(const float4*)&Ks[j][d]; z += q[d] * kv.x + q[d + 1] * kv.y + q[d + 2] * kv.z + q[d + 3] * kv.w; }
            const float sp = fmaxf(z, 0.f) + log1pf(expf(-fabsf(z)));
            const bool valid = kj < t;
            const float a = valid ? expf(z - sp + R) : 0.f;
            if (valid) R -= sp;
#pragma unroll
            for (int d = 0; d < 64; d += 4) { const float4 vv = *(const float4*)&Vs[j][d]; o[d] += a * vv.x; o[d + 1] += a * vv.y; o[d + 2] += a * vv.z; o[d + 3] += a * vv.w; }
        }
        if (__all(R < -110.f)) break;
    }
    float ss = 0.f;
#pragma unroll
    for (int d = 0; d < 64; ++d) ss += o[d] * o[d];
    const float rs = rsqrtf(ss * (1.f / 64.f) + 1e-6f);
    bf16_t* yp = Y + ((long)b * SEQ + t) * DM + h * 64;
#pragma unroll
    for (int d = 0; d < 64; d += 4) {
        const float4 gv = *(const float4*)(gain + h * 64 + d);
        u32x2 w; w.x = pk2(o[d] * rs * gv.x, o[d + 1] * rs * gv.y); w.y = pk2(o[d + 2] * rs * gv.z, o[d + 3] * rs * gv.w);
        *(u32x2*)(yp + d) = w;
    }
}
__global__ void __launch_bounds__(64) dil_attn_naive(const bf16_t* __restrict__ proj, const float* __restrict__ rel_bias, const float* __restrict__ gain, bf16_t* __restrict__ Y) {
    __shared__ float bt[32];
    const int lane = threadIdx.x, h = blockIdx.y, b = blockIdx.z;
    const int t = blockIdx.x * 64 + lane;
    if (lane < 32) bt[lane] = rel_bias[lane * 8 + h];
    __syncthreads();
    const bf16_t* base = proj + (long)b * SEQ * NPROJ;
    float q[64], o[64];
    {
        const bf16_t* qp = base + (long)t * NPROJ + 1536 + h * 64;
#pragma unroll
        for (int d = 0; d < 64; d += 8) ld8bf(qp + d, q + d);
#pragma unroll
        for (int d = 0; d < 64; ++d) { q[d] *= LN2; o[d] = 0.f; }
    }
    float m = -1e30f, l = 0.f;
    for (int br = 0; br < 3; ++br) {
        const int dil = br == 0 ? 1 : (br == 1 ? 4 : 16);
        for (int st = 0; st <= 128; ++st) {
            const int j = t - st * dil;
            if (j < 0) break;
            const bf16_t* kp = base + (long)j * NPROJ + 2048 + h * 64;
            float z = 0.f;
#pragma unroll
            for (int d = 0; d < 64; d += 8) { float kv[8]; ld8bf(kp + d, kv);
#pragma unroll
                for (int jj = 0; jj < 8; ++jj) z += q[d + jj] * kv[jj]; }
            z += bt[t5_bucket(st * dil)];
            const float mn = fmaxf(m, z), sc = expf(m - mn), p = expf(z - mn);
            l = l * sc + p; m = mn;
            const bf16_t* vp = kp + 512;
#pragma unroll
            for (int d = 0; d < 64; d += 8) { float vv[8]; ld8bf(vp + d, vv);
#pragma unroll
                for (int jj = 0; jj < 8; ++jj) o[d + jj] = o[d + jj] * sc + p * vv[jj]; }
        }
    }
    const float il = 1.f / l;
    float ss = 0.f;
#pragma unroll
    for (int d = 0; d < 64; ++d) { o[d] *= il; ss += o[d] * o[d]; }
    const float rs = rsqrtf(ss * (1.f / 64.f) + 1e-6f);
    bf16_t* yp = Y + ((long)b * SEQ + t) * DM + 512 + h * 64;
#pragma unroll
    for (int d = 0; d < 64; d += 4) {
        const float4 gv = *(const float4*)(gain + h * 64 + d);
        u32x2 w; w.x = pk2(o[d] * rs * gv.x, o[d + 1] * rs * gv.y); w.y = pk2(o[d + 2] * rs * gv.z, o[d + 3] * rs * gv.w);
        *(u32x2*)(yp + d) = w;
    }
}
__global__ void __launch_bounds__(256) ln_route_naive(const float* __restrict__ T, const float* __restrict__ g, const float* __restrict__ bb, float* __restrict__ X1, bf16_t* __restrict__ X1B,
                                                      const float* __restrict__ wr, const float* __restrict__ br, int* __restrict__ cnt, int* __restrict__ perm, TokInfo* __restrict__ info) {
    const int lane = threadIdx.x & 63, row = blockIdx.x * 4 + (threadIdx.x >> 6);
    const float4* xr = (const float4*)(T + (long)row * DM) + lane;
    float4 v[4]; float s = 0.f;
#pragma unroll
    for (int j = 0; j < 4; ++j) { v[j] = xr[64 * j]; s += (v[j].x + v[j].y) + (v[j].z + v[j].w); }
    const float mean = wave_sum(s) * (1.f / DM); float s2 = 0.f;
#pragma unroll
    for (int j = 0; j < 4; ++j) { v[j].x -= mean; v[j].y -= mean; v[j].z -= mean; v[j].w -= mean; s2 += (v[j].x * v[j].x + v[j].y * v[j].y) + (v[j].z * v[j].z + v[j].w * v[j].w); }
    const float rstd = rsqrtf(wave_sum(s2) * (1.f / DM) + LN_EPS);
    float4* o4 = (float4*)(X1 + (long)row * DM) + lane; unsigned long long* o8 = (unsigned long long*)(X1B + (long)row * DM) + lane;
    float acc[16];
#pragma unroll
    for (int e = 0; e < 16; ++e) acc[e] = 0.f;
#pragma unroll
    for (int j = 0; j < 4; ++j) {
        const float4 gv = ((const float4*)g)[lane + 64 * j], bv = ((const float4*)bb)[lane + 64 * j];
        const float4 y = make_float4(v[j].x * rstd * gv.x + bv.x, v[j].y * rstd * gv.y + bv.y, v[j].z * rstd * gv.z + bv.z, v[j].w * rstd * gv.w + bv.w);
        o4[64 * j] = y; o8[64 * j] = (unsigned long long)pk2(y.x, y.y) | ((unsigned long long)pk2(y.z, y.w) << 32);
        const float yy[4] = {y.x, y.y, y.z, y.w};
#pragma unroll
        for (int c = 0; c < 4; ++c) { const float4* w4 = (const float4*)(wr + (long)(4 * lane + 256 * j + c) * 16);
#pragma unroll
            for (int e4 = 0; e4 < 4; ++e4) { const float4 w = w4[e4]; acc[e4 * 4] += yy[c] * w.x; acc[e4 * 4 + 1] += yy[c] * w.y; acc[e4 * 4 + 2] += yy[c] * w.z; acc[e4 * 4 + 3] += yy[c] * w.w; } }
    }
    float mx = -1e30f;
#pragma unroll
    for (int e = 0; e < 16; ++e) { acc[e] = wave_sum(acc[e]) + br[e]; mx = fmaxf(mx, acc[e]); }
    float p[16];
#pragma unroll
    for (int e = 0; e < 16; ++e) p[e] = expf(acc[e] - mx);
    float best = -1.f; int be1 = 0, be2 = 0; float bv1 = 0.f, bv2 = 0.f;
#pragma unroll
    for (int gI = 0; gI < 4; ++gI) {
        float v1 = -1.f, v2 = -1.f; int i1 = 0, i2 = 0;
#pragma unroll
        for (int j = 0; j < 4; ++j) { const float pv = p[gI * 4 + j];
            if (pv > v1) { v2 = v1; i2 = i1; v1 = pv; i1 = j; } else if (pv > v2) { v2 = pv; i2 = j; } }
        const float sm = v1 + v2;
        if (sm > best) { best = sm; be1 = gI * 4 + i1; be2 = gI * 4 + i2; bv1 = v1; bv2 = v2; }
    }
    if (lane == 0) {
        const int s1 = atomicAdd(&cnt[be1], 1), sl2 = atomicAdd(&cnt[be2], 1);
        perm[be1 * NTOK + s1] = row; perm[be2 * NTOK + sl2] = row;
        TokInfo ti; ti.e1 = be1; ti.e2 = be2; ti.s1 = s1; ti.s2 = sl2; ti.g1 = bv1 / (bv1 + bv2); ti.g2 = bv2 / (bv1 + bv2); ti.pad0 = 0; ti.pad1 = 0;
        info[row] = ti;
    }
}
__global__ void scan16(const int* __restrict__ cnt, int* __restrict__ off) {
    if (threadIdx.x == 0) { int s = 0; for (int e = 0; e < 16; ++e) { off[e] = s; s += ((cnt[e] + 255) >> 8) << 8; } }
}
__global__ void __launch_bounds__(256) combine_naive(const float* __restrict__ X1, const bf16_t* __restrict__ YP, const TokInfo* __restrict__ info, const int* __restrict__ cnt,
                                                     const float* __restrict__ g, const float* __restrict__ bb, float* __restrict__ out, bf16_t* __restrict__ outb) {
    const int lane = threadIdx.x & 63, row = blockIdx.x * 4 + (threadIdx.x >> 6);
    const TokInfo ti = info[row];
    int off1 = 0, off2 = 0;
    for (int e = 0; e < 16; ++e) { const int pc = ((cnt[e] + 255) >> 8) << 8; if (e < ti.e1) off1 += pc; if (e < ti.e2) off2 += pc; }
    const float4* xr = (const float4*)(X1 + (long)row * DM) + lane;
    const u32x2* y1 = (const u32x2*)(YP + (long)(off1 + ti.s1) * DM) + lane;
    const u32x2* y2 = (const u32x2*)(YP + (long)(off2 + ti.s2) * DM) + lane;
    float4 v[4]; float s = 0.f;
#pragma unroll
    for (int j = 0; j < 4; ++j) {
        const float4 x = xr[64 * j]; const u32x2 a = y1[64 * j], c = y2[64 * j];
        v[j].x = ALPHA * x.x + (ti.g1 * __uint_as_float(a.x << 16) + ti.g2 * __uint_as_float(c.x << 16));
        v[j].y = ALPHA * x.y + (ti.g1 * __uint_as_float(a.x & 0xffff0000u) + ti.g2 * __uint_as_float(c.x & 0xffff0000u));
        v[j].z = ALPHA * x.z + (ti.g1 * __uint_as_float(a.y << 16) + ti.g2 * __uint_as_float(c.y << 16));
        v[j].w = ALPHA * x.w + (ti.g1 * __uint_as_float(a.y & 0xffff0000u) + ti.g2 * __uint_as_float(c.y & 0xffff0000u));
        s += (v[j].x + v[j].y) + (v[j].z + v[j].w);
    }
    const float mean = wave_sum(s) * (1.f / DM); float s2 = 0.f;
#pragma unroll
    for (int j = 0; j < 4; ++j) { v[j].x -= mean; v[j].y -= mean; v[j].z -= mean; v[j].w -= mean; s2 += (v[j].x * v[j].x + v[j].y * v[j].y) + (v[j].z * v[j].z + v[j].w * v[j].w); }
    const float rstd = rsqrtf(wave_sum(s2) * (1.f / DM) + LN_EPS);
    float4* o4 = (float4*)(out + (long)row * DM) + lane; unsigned long long* o8 = (unsigned long long*)(outb + (long)row * DM) + lane;
#pragma unroll
    for (int j = 0; j < 4; ++j) {
        const float4 gv = ((const float4*)g)[lane + 64 * j], bv = ((const float4*)bb)[lane + 64 * j];
        const float4 y = make_float4(v[j].x * rstd * gv.x + bv.x, v[j].y * rstd * gv.y + bv.y, v[j].z * rstd * gv.z + bv.z, v[j].w * rstd * gv.w + bv.w);
        o4[64 * j] = y; o8[64 * j] = (unsigned long long)pk2(y.x, y.y) | ((unsigned long long)pk2(y.z, y.w) << 32);
    }
}

static void launch_mk(Args a, int lo, int hi, int grid, hipStream_t stream) {
    a.ph_lo = lo; a.ph_hi = hi;
    hipLaunchKernelGGL(mk, dim3(grid), dim3(NWAVES * 64), LDS_BYTES, stream, a);
}
extern "C" void kernel_launch(void* const* d_in, const int* in_sizes, int n_in, void* d_out, int out_size, void* d_ws, size_t ws_size, hipStream_t stream) {
    static int grid = 0;
    if (grid == 0) {
        if (n_in != 15 || ws_size < WS_END) { fprintf(stderr, "kernel_launch: unexpected n_in %d / ws %zu\n", n_in, ws_size); grid = -1; return; }
        if (hipFuncSetAttribute((const void*)mk, hipFuncAttributeMaxDynamicSharedMemorySize, LDS_BYTES) != hipSuccess) { fprintf(stderr, "hipFuncSetAttribute failed\n"); grid = -1; return; }
        int dev = 0, cus = 0; (void)hipGetDevice(&dev); (void)hipDeviceGetAttribute(&cus, hipDeviceAttributeMultiprocessorCount, dev);
        grid = cus > 0 ? cus : 256;
    }
    if (grid < 0) return;
    (void)hipMemsetAsync((char*)d_ws + WS_CTL, 0, CTL_ZERO_BYTES, stream);
    Args a{};
    for (int i = 0; i < 15; ++i) a.in[i] = (const float*)d_in[i];
    a.out = (float*)d_out; a.ws = (unsigned char*)d_ws;
    char* ws = (char*)d_ws;
    const float* x = a.in[0]; const float* w_in = a.in[1]; const float* g_sb = a.in[2]; const float* g_dil = a.in[3]; const float* w_out = a.in[4];
    const float* ln1_g = a.in[5]; const float* ln1_b = a.in[6]; const float* ln2_g = a.in[7]; const float* ln2_b = a.in[8]; const float* rel_bias = a.in[9];
    const float* w_router = a.in[10]; const float* b_router = a.in[11]; const float* w_gate = a.in[12]; const float* w_up = a.in[13]; const float* w_down = a.in[14];
    int* ctl = (int*)(ws + WS_CTL); int* perm = (int*)(ws + WS_PERM); TokInfo* info = (TokInfo*)(ws + WS_INFO);
    bf16_t* XB = (bf16_t*)(ws + WS_XB); float* XC = (float*)(ws + WS_XC); bf16_t* PROJ = (bf16_t*)(ws + WS_PROJ); bf16_t* HB = (bf16_t*)(ws + WS_H);
    bf16_t* Y = (bf16_t*)(ws + WS_Y); float* T = (float*)(ws + WS_T); bf16_t* YP = (bf16_t*)(ws + WS_YP); float* X1 = (float*)(ws + WS_X1); bf16_t* X1B = (bf16_t*)(ws + WS_X1B);
#if ONE_LAUNCH
    launch_mk(a, 0, N_PHASES, grid, stream);
    (void)ctl; (void)perm; (void)info; (void)XB; (void)XC; (void)PROJ; (void)HB; (void)Y; (void)T; (void)YP; (void)X1; (void)X1B; (void)x; (void)w_in; (void)g_sb; (void)g_dil; (void)w_out;
    (void)ln1_g; (void)ln1_b; (void)ln2_g; (void)ln2_b; (void)rel_bias; (void)w_router; (void)b_router; (void)w_gate; (void)w_up; (void)w_down;
#else
    for (int l = 0; l < DEPTH; ++l) {
        const int pb = l * PH_PER_LAYER;
        int* cntl = ctl + CW_CNT + l * 16; int* offl = ctl + CW_OFF + l * 16;
        const float* xres = l == 0 ? x : XC;
        launch_mk(a, pb + PH_W, pb + PH_W + 1, grid, stream);
#if FAST_GEMM
        launch_mk(a, pb + PH_QKV, pb + PH_QKV + 1, grid, stream);
#else
        { NGemm g{}; g.A = XB; g.lda = DM; g.B = w_in + (size_t)l * DM * NPROJ; g.ldb = NPROJ; g.C = PROJ; g.ldc = NPROJ; g.M = NTOK; g.K = DM;
          hipLaunchKernelGGL(ngemm<0>, dim3(NPROJ / 64, NTOK / 64, 1), dim3(256), 0, stream, g); }
#endif
#if FAST_ATT
        launch_mk(a, pb + PH_ATT, pb + PH_ATT + 1, grid, stream);
#else
        hipLaunchKernelGGL(sb_attn_naive, dim3(SEQ / 64, 8, BATCH), dim3(64), 0, stream, PROJ, g_sb + l * 512, Y);
        hipLaunchKernelGGL(dil_attn_naive, dim3(SEQ / 64, 8, BATCH), dim3(64), 0, stream, PROJ, rel_bias, g_dil + l * 512, Y);
#endif
#if FAST_GEMM
        launch_mk(a, pb + PH_OUT, pb + PH_OUT + 1, grid, stream);
#else
        { NGemm g{}; g.A = Y; g.lda = DM; g.B = w_out + (size_t)l * DM * DM; g.ldb = DM; g.C = T; g.ldc = DM; g.M = NTOK; g.K = DM; g.R = xres;
          hipLaunchKernelGGL(ngemm<1>, dim3(DM / 64, NTOK / 64, 1), dim3(256), 0, stream, g); }
#endif
#if FAST_THIN
        launch_mk(a, pb + PH_LNR, pb + PH_LNR + 1, grid, stream);
#else
        hipLaunchKernelGGL(ln_route_naive, dim3(NTOK / 4), dim3(256), 0, stream, T, ln1_g + l * DM, ln1_b + l * DM, X1, X1B, w_router, b_router, cntl, perm, info);
#endif
#if FAST_GEMM
        launch_mk(a, pb + PH_MOE1, pb + PH_MOE1 + 1, grid, stream);
        launch_mk(a, pb + PH_MOE2, pb + PH_MOE2 + 1, grid, stream);
#else
        hipLaunchKernelGGL(scan16, dim3(1), dim3(64), 0, stream, cntl, offl);
        { NGemm g{}; g.A = X1B; g.lda = DM; g.rowmap = perm; g.cnt = cntl; g.coff = offl;
          g.B = w_gate + (size_t)l * NEXP * DM * FF; g.B2 = w_up + (size_t)l * NEXP * DM * FF; g.bstride = (long)DM * FF; g.ldb = FF; g.C = HB; g.ldc = FF; g.M = NTOK; g.K = DM;
          hipLaunchKernelGGL(ngemm<2>, dim3(FF / 64, NTOK / 64, NEXP), dim3(256), 0, stream, g); }
        { NGemm g{}; g.A = HB; g.lda = FF; g.cnt = cntl; g.coff = offl;
          g.B = w_down + (size_t)l * NEXP * FF * DM; g.bstride = (long)FF * DM; g.ldb = DM; g.C = YP; g.ldc = DM; g.M = NTOK; g.K = FF;
          hipLaunchKernelGGL(ngemm<3>, dim3(DM / 64, NTOK / 64, NEXP), dim3(256), 0, stream, g); }
#endif
#if FAST_THIN
        launch_mk(a, pb + PH_COMB, pb + PH_COMB + 1, grid, stream);
#else
        float* xo = (l == DEPTH - 1) ? (float*)d_out : XC;
        hipLaunchKernelGGL(combine_naive, dim3(NTOK / 4), dim3(256), 0, stream, X1, YP, info, cntl, ln2_g + l * DM, ln2_b + l * DM, xo, XB);
#endif
    }
#endif
}
```

```cpp
#include <hip/hip_runtime.h>
#include <cstdio>
#include <cstdint>

constexpr int BATCH = 2, SEQ = 8192, DM = 1024, NTOK = BATCH * SEQ, NPROJ = 3072, NEXP = 16, DEPTH = 2, FF = 1024;
constexpr float ALPHA = 1.4142135623730951f;
constexpr float LN_EPS = 1e-5f;
constexpr float LOG2E = 1.4426950408889634f, LN2 = 0.6931471805599453f;
constexpr float QSCALE = 0.125f * LOG2E;

#ifndef ONE_LAUNCH
#define ONE_LAUNCH 1
#endif
#ifndef DUP_PHASE
#define DUP_PHASE -1
#endif
#ifndef PROBE_M
#define PROBE_M -1
#endif
#define REPS(k) for (int rep_ = 0; rep_ < ((DUP_PHASE) == (k) ? 2 : 1); ++rep_)

typedef unsigned short bf16_t;
#define LAS __attribute__((address_space(3)))
#define GAS __attribute__((address_space(1)))
typedef float f32x4 __attribute__((ext_vector_type(4)));
typedef float f32x2 __attribute__((ext_vector_type(2)));
typedef float f32x16 __attribute__((ext_vector_type(16)));
typedef short bf16x8 __attribute__((ext_vector_type(8)));
typedef unsigned u32x4 __attribute__((ext_vector_type(4)));
typedef unsigned u32x2 __attribute__((ext_vector_type(2)));

__device__ __forceinline__ float bf2f(bf16_t v) { return __uint_as_float((unsigned)v << 16); }
__device__ __forceinline__ unsigned f2bf(float f) { unsigned u = __float_as_uint(f); return (u + 0x7fffu + ((u >> 16) & 1u)) >> 16; }
__device__ __forceinline__ unsigned pk2(float lo, float hi) { return f2bf(lo) | (f2bf(hi) << 16); }
__device__ __forceinline__ unsigned cvt_pk_bf16(float lo, float hi) { unsigned r; asm volatile("v_cvt_pk_bf16_f32 %0, %1, %2" : "=v"(r) : "v"(lo), "v"(hi)); return r; }

constexpr size_t MiB = 1u << 20;
constexpr size_t WS_CTL = 0, CTL_ZERO_BYTES = 65536;
constexpr size_t WS_PERM = 1 * MiB, WS_INFO = 2 * MiB;
constexpr size_t WS_WIN = 4 * MiB  , WS_WOUT = 16 * MiB, WS_WGU = 18 * MiB, WS_WD = 82 * MiB;
constexpr size_t WS_XB = 114 * MiB, WS_PROJ = 146 * MiB, WS_H = 146 * MiB;
constexpr size_t WS_Y = 242 * MiB, WS_T = 274 * MiB  , WS_X1B = 306 * MiB, WS_YP = 338 * MiB, WS_END = 410 * MiB;
constexpr int CW_TMO = 0, CW_OFF = 128  , CW_CNT = 4096  , CW_BAR = 8192;

struct TokInfo { int e1, e2, s1, s2; float g1, g2; int pad0, pad1; };

namespace pg8 {
constexpr int BM = 256, BK = 64, HALF = 128, HTB = HALF * BK * 2, STAGE_BYTES = 8 * HTB;
__host__ __device__ __forceinline__ int lds_byte(int r, int c) { const int st = (r >> 4) * 2 + (c >> 5), rr = r & 15, cc = c & 31, ob = rr * 64 + cc * 2; return st * 1024 + (ob ^ (((ob >> 9) & 1) << 5)); }
__host__ __device__ __forceinline__ void stage_rc(int b, int& R, int& C) { const int st = b / 1024, sb = b % 1024, swz = sb ^ (((sb >> 9) & 1) << 5); R = (st >> 1) * 16 + swz / 64; C = (st & 1) * 32 + (swz % 64) / 2; }
__host__ __device__ __forceinline__ int perm32(int rho) { const int n = rho >> 4, i = rho & 15; return 8 * (i >> 2) + 4 * n + (i & 3); }

struct Unit { int pm, pn, e; };

struct EpiProj {
    static constexpr bool PERM = true;
    bf16_t* O;
    __device__ __forceinline__ void operator()(const f32x4 (&acc)[2][2][4][2], const Unit& u, int wr, int wc, int fr, int fq) const {
        const int row0 = u.pm * BM + wr * 64 + fr; const int col0 = u.pn * BM + wc * 32 + 8 * fq;
        const float sc = (u.pn < 2 || u.pn == 6 || u.pn == 7) ? QSCALE : 1.f;
#pragma unroll
        for (int ai = 0; ai < 2; ++ai)
#pragma unroll
            for (int m = 0; m < 4; ++m) { bf16_t* rowp = O + (size_t)(row0 + ai * HALF + m * 16) * NPROJ + col0;
#pragma unroll
                for (int bj = 0; bj < 2; ++bj) { const f32x4 v0 = acc[ai][bj][m][0] * sc, v1 = acc[ai][bj][m][1] * sc;
                    u32x4 w; w.x = cvt_pk_bf16(v0[0], v0[1]); w.y = cvt_pk_bf16(v0[2], v0[3]); w.z = cvt_pk_bf16(v1[0], v1[1]); w.w = cvt_pk_bf16(v1[2], v1[3]);
                    *(u32x4*)(rowp + bj * HALF) = w; } }
    }
};
struct EpiPlain {
    static constexpr bool PERM = true;
    bf16_t* O; int ldc;
    __device__ __forceinline__ void operator()(const f32x4 (&acc)[2][2][4][2], const Unit& u, int wr, int wc, int fr, int fq) const {
        const int row0 = u.pm * BM + wr * 64 + fr; const int col0 = u.pn * BM + wc * 32 + 8 * fq;
#pragma unroll
        for (int ai = 0; ai < 2; ++ai)
#pragma unroll
            for (int m = 0; m < 4; ++m) { bf16_t* rowp = O + (size_t)(row0 + ai * HALF + m * 16) * ldc + col0;
#pragma unroll
                for (int bj = 0; bj < 2; ++bj) { const f32x4 v0 = acc[ai][bj][m][0], v1 = acc[ai][bj][m][1];
                    u32x4 w; w.x = cvt_pk_bf16(v0[0], v0[1]); w.y = cvt_pk_bf16(v0[2], v0[3]); w.z = cvt_pk_bf16(v1[0], v1[1]); w.w = cvt_pk_bf16(v1[2], v1[3]);
                    *(u32x4*)(rowp + bj * HALF) = w; } }
    }
};
template <bool RES_F32> struct EpiRes {
    static constexpr bool PERM = true;
    const float* Xf; const bf16_t* Xb; bf16_t* T;
    __device__ __forceinline__ void operator()(const f32x4 (&acc)[2][2][4][2], const Unit& u, int wr, int wc, int fr, int fq) const {
        const int row0 = u.pm * BM + wr * 64 + fr; const int col0 = u.pn * BM + wc * 32 + 8 * fq;
#pragma unroll
        for (int ai = 0; ai < 2; ++ai)
#pragma unroll
            for (int m = 0; m < 4; ++m) { const size_t off = (size_t)(row0 + ai * HALF + m * 16) * DM + col0;
#pragma unroll
                for (int bj = 0; bj < 2; ++bj) { f32x4 x0, x1;
                    if (RES_F32) { x0 = *(const f32x4*)(Xf + off + bj * HALF); x1 = *(const f32x4*)(Xf + off + bj * HALF + 4); }
                    else { const u32x4 w = *(const u32x4*)(Xb + off + bj * HALF);
                        x0 = (f32x4){__uint_as_float(w.x << 16), __uint_as_float(w.x & 0xffff0000u), __uint_as_float(w.y << 16), __uint_as_float(w.y & 0xffff0000u)};
                        x1 = (f32x4){__uint_as_float(w.z << 16), __uint_as_float(w.z & 0xffff0000u), __uint_as_float(w.w << 16), __uint_as_float(w.w & 0xffff0000u)}; }
                    const f32x4 v0 = x0 * ALPHA + acc[ai][bj][m][0], v1 = x1 * ALPHA + acc[ai][bj][m][1];
                    u32x4 o; o.x = cvt_pk_bf16(v0[0], v0[1]); o.y = cvt_pk_bf16(v0[2], v0[3]); o.z = cvt_pk_bf16(v1[0], v1[1]); o.w = cvt_pk_bf16(v1[2], v1[3]);
                    *(u32x4*)(T + off + bj * HALF) = o; } }
    }
};
struct EpiSwiGLU {
    static constexpr bool PERM = true;
    bf16_t* O;
    __device__ __forceinline__ void operator()(const f32x4 (&acc)[2][2][4][2], const Unit& u, int wr, int wc, int fr, int fq) const {
        const int row0 = u.pm * BM + wr * 64 + fr; const int col0 = u.pn * HALF + wc * 32 + 8 * fq;
#pragma unroll
        for (int ai = 0; ai < 2; ++ai)
#pragma unroll
            for (int m = 0; m < 4; ++m) { bf16_t* rowp = O + (size_t)(row0 + ai * HALF + m * 16) * FF + col0;
                float h[8];
#pragma unroll
                for (int n = 0; n < 2; ++n)
#pragma unroll
                    for (int j = 0; j < 4; ++j) { const float g = acc[ai][0][m][n][j], up = acc[ai][1][m][n][j];
                        h[n * 4 + j] = g * __builtin_amdgcn_rcpf(1.f + __builtin_amdgcn_exp2f(-g * LOG2E)) * up; }
                u32x4 w; w.x = cvt_pk_bf16(h[0], h[1]); w.y = cvt_pk_bf16(h[2], h[3]); w.z = cvt_pk_bf16(h[4], h[5]); w.w = cvt_pk_bf16(h[6], h[7]);
                *(u32x4*)rowp = w; }
    }
};

template <class Epi, class Sched, bool GATHER, bool ALIGN_EPI>
__device__ __forceinline__ void gemm_phase(LAS unsigned char* lds, const int K, const Sched& S, const Epi& E) {
    int tid_l = threadIdx.x; asm volatile("" : "+v"(tid_l));
    const int tid = tid_l, wid = __builtin_amdgcn_readfirstlane(tid >> 6), lane = tid & 63, wr = wid >> 2, wc = wid & 3, fr = lane & 15, fq = lane >> 4;
    const int nt = K / BK;
    unsigned voffA[2], voffB[2]; int gR[2];
#pragma unroll
    for (int i = 0; i < 2; ++i) { int R, C; stage_rc(tid * 16 + i * 8192, R, C); const int Rb = Epi::PERM ? ((R & ~31) + perm32(R & 31)) : R;
        voffA[i] = GATHER ? (unsigned)(C * 2) : (unsigned)(R * K + C) * 2u; voffB[i] = (unsigned)(Rb * K + C) * 2u; gR[i] = R; }
    const size_t kstep = (size_t)(BK * 2);
    const size_t hstep = (size_t)HALF * K * 2;
    const unsigned ldsw = (unsigned)wid * 1024u;
    const int aoff = lds_byte(wr * 64 + fr, fq * 8), boff = lds_byte(wc * 32 + fr, fq * 8);
    unsigned goff[2][2];
#define PG8_SA(b, h) (((b) * 2 + (h)) * HTB)
#define PG8_SB(b, h) ((4 + (b) * 2 + (h)) * HTB)
#define PG8_GLDS(gp, bufoff, i) __builtin_amdgcn_global_load_lds((const unsigned*)(gp), (LAS unsigned*)(lds + (bufoff) + ldsw + (i) * 8192), 16, 0, 0)
#define PG8_STAGE_B(bufoff, gbase) do { _Pragma("unroll") for (int _i = 0; _i < 2; ++_i) PG8_GLDS((const char*)(gbase) + voffB[_i], bufoff, _i); } while (0)
#define PG8_STAGE_A(bufoff, gbase, h) do { _Pragma("unroll") for (int _i = 0; _i < 2; ++_i) { \
        if constexpr (GATHER) PG8_GLDS((const char*)(gbase) + goff[h][_i], bufoff, _i); else PG8_GLDS((const char*)(gbase) + (size_t)(h) * hstep + voffA[_i], bufoff, _i); } } while (0)
#define PG8_LDA(dst, b, h) do { _Pragma("unroll") for (int m = 0; m < 4; ++m) _Pragma("unroll") for (int k = 0; k < 2; ++k) dst[m][k] = *(const LAS bf16x8*)(lds + PG8_SA(b, h) + aoff + m * 2048 + k * 1024); } while (0)
#define PG8_LDB(dst, b, h) do { _Pragma("unroll") for (int n = 0; n < 2; ++n) _Pragma("unroll") for (int k = 0; k < 2; ++k) dst[n][k] = *(const LAS bf16x8*)(lds + PG8_SB(b, h) + boff + n * 2048 + k * 1024); } while (0)
#define PG8_MMA(ai, bj, At, Bt) do { __builtin_amdgcn_s_setprio(1); _Pragma("unroll") for (int m = 0; m < 4; ++m) _Pragma("unroll") for (int n = 0; n < 2; ++n) _Pragma("unroll") for (int k = 0; k < 2; ++k) \
        acc[ai][bj][m][n] = __builtin_amdgcn_mfma_f32_16x16x32_bf16(Bt[n][k], At[m][k], acc[ai][bj][m][n], 0, 0, 0); __builtin_amdgcn_s_setprio(0); } while (0)
#define PG8_WAIT_V(n) asm volatile("s_waitcnt vmcnt(" #n ")" ::: "memory")
#define PG8_WAIT_L(n) asm volatile("s_waitcnt lgkmcnt(" #n ")" ::: "memory")
#define PG8_BAR __builtin_amdgcn_s_barrier()
#define PG8_SCHED __builtin_amdgcn_sched_barrier(0)
#define PG8_GOFF(uidx) do { if constexpr (GATHER) { _Pragma("unroll") for (int _h = 0; _h < 2; ++_h) _Pragma("unroll") for (int _i = 0; _i < 2; ++_i) goff[_h][_i] = S.grow(uidx, _h * HALF + gR[_i]) + voffA[_i]; } } while (0)
    Unit cur, nxt; int ui = 0;
    if (!S.next(0, cur)) return;
    f32x4 acc[2][2][4][2];
#pragma unroll
    for (int a = 0; a < 2; ++a)
#pragma unroll
        for (int b = 0; b < 2; ++b)
#pragma unroll
            for (int m = 0; m < 4; ++m)
#pragma unroll
                for (int n = 0; n < 2; ++n) acc[a][b][m][n] = (f32x4){0.f, 0.f, 0.f, 0.f};
    bf16x8 At[4][2], B0[2][2], B1[2][2];
    const char* cA = S.a_base(cur); const char* cB = S.b_base(cur);
    PG8_GOFF(0);
    PG8_STAGE_B(PG8_SB(0, 0), cB); PG8_STAGE_B(PG8_SB(0, 1), cB + hstep); PG8_STAGE_A(PG8_SA(0, 0), cA, 0); PG8_STAGE_A(PG8_SA(0, 1), cA, 1);
    if (wr == 1) PG8_BAR;
    PG8_WAIT_V(2); PG8_BAR;
    PG8_STAGE_B(PG8_SB(1, 0), cB + kstep); PG8_STAGE_A(PG8_SA(1, 0), cA + kstep, 0); PG8_STAGE_B(PG8_SB(1, 1), cB + hstep + kstep);
    PG8_WAIT_V(6); PG8_BAR;
    for (;;) {
        const bool has_next = S.next(ui + 1, nxt);
        const char* nA = has_next ? S.a_base(nxt) : cA; const char* nB = has_next ? S.b_base(nxt) : cB;
        for (int t = 0; t < nt; t += 2) {
            const bool last = (t == nt - 2);
            const char* a1 = cA + (size_t)(t + 1) * kstep;
            const char* a2 = last ? nA : cA + (size_t)(t + 2) * kstep; const char* b2 = last ? nB : cB + (size_t)(t + 2) * kstep;
            const char* a3 = a2 + kstep; const char* b3 = b2 + kstep;
            PG8_LDB(B0, 0, 0); PG8_LDB(B1, 0, 1); PG8_SCHED; PG8_LDA(At, 0, 0); PG8_STAGE_A(PG8_SA(1, 1), a1, 1);
            if (GATHER && last && has_next) { PG8_GOFF(ui + 1); }
            PG8_WAIT_V(8); PG8_WAIT_L(0); PG8_BAR; PG8_MMA(0, 0, At, B0); PG8_MMA(0, 1, At, B1); PG8_BAR; PG8_SCHED;
            PG8_LDA(At, 0, 1); PG8_STAGE_B(PG8_SB(0, 0), b2); PG8_STAGE_B(PG8_SB(0, 1), b2 + hstep); PG8_STAGE_A(PG8_SA(0, 0), a2, 0);
            PG8_WAIT_V(8); PG8_WAIT_L(0); PG8_BAR; PG8_MMA(1, 0, At, B0); PG8_MMA(1, 1, At, B1); PG8_BAR; PG8_SCHED;
            PG8_LDB(B0, 1, 0); PG8_LDB(B1, 1, 1); PG8_SCHED; PG8_LDA(At, 1, 0); PG8_STAGE_A(PG8_SA(0, 1), a2, 1);
            PG8_WAIT_V(8); PG8_WAIT_L(0); PG8_BAR; PG8_MMA(0, 0, At, B0); PG8_MMA(0, 1, At, B1); PG8_BAR; PG8_SCHED;
            PG8_LDA(At, 1, 1); PG8_STAGE_B(PG8_SB(1, 0), b3); PG8_STAGE_B(PG8_SB(1, 1), b3 + hstep); PG8_STAGE_A(PG8_SA(1, 0), a3, 0);
            PG8_WAIT_V(8); PG8_WAIT_L(0); PG8_BAR; PG8_MMA(1, 0, At, B0); PG8_MMA(1, 1, At, B1); PG8_BAR; PG8_SCHED;
        }
        if constexpr (ALIGN_EPI) { if (wr == 0) PG8_BAR; }
        E(acc, cur, wr, wc, fr, fq);
        if (!has_next) break;
#pragma unroll
        for (int a = 0; a < 2; ++a)
#pragma unroll
            for (int b = 0; b < 2; ++b)
#pragma unroll
                for (int m = 0; m < 4; ++m)
#pragma unroll
                    for (int n = 0; n < 2; ++n) acc[a][b][m][n] = (f32x4){0.f, 0.f, 0.f, 0.f};
        cur = nxt; cA = nA; cB = nB; ++ui;
        if constexpr (ALIGN_EPI) { if (wr == 1) PG8_BAR; }
    }
    PG8_WAIT_V(0);
    if constexpr (!ALIGN_EPI) { if (wr == 0) PG8_BAR; }
    PG8_BAR;
#undef PG8_SA
#undef PG8_SB
#undef PG8_GLDS
#undef PG8_STAGE_A
#undef PG8_STAGE_B
#undef PG8_LDA
#undef PG8_LDB
#undef PG8_MMA
#undef PG8_WAIT_V
#undef PG8_WAIT_L
#undef PG8_BAR
#undef PG8_SCHED
#undef PG8_GOFF
}

struct DenseSched {
    int nM, nN, nwg, G, c; const char* A; const char* Bt; size_t tstep;
    __device__ __forceinline__ void init(int M, int N, int K, int G_, int c_, const void* A_, const void* Bt_) { nM = M / BM; nN = N / BM; nwg = nM * nN; G = G_; c = c_; A = (const char*)A_; Bt = (const char*)Bt_; tstep = (size_t)BM * K * 2; }
    __device__ __forceinline__ bool next(int i, Unit& u) const {
        const long L = (long)i * G + c; if (L >= nwg) return false;
        int wgid = (int)L; { const int q = nwg / 8, r = nwg % 8, xcd = wgid % 8, off = wgid / 8; wgid = (xcd < r ? xcd * (q + 1) : r * (q + 1) + (xcd - r) * q) + off; }
        const int nig = 8 * nN, gid = wgid / nig, fm = gid * 8, gsz = (nM - fm) < 8 ? (nM - fm) : 8;
        u.pm = fm + ((wgid % nig) % gsz); u.pn = (wgid % nig) / gsz; u.e = 0; return true;
    }
    __device__ __forceinline__ const char* a_base(const Unit& u) const { return A + (size_t)u.pm * tstep; }
    __device__ __forceinline__ const char* b_base(const Unit& u) const { return Bt + (size_t)u.pn * tstep; }
    __device__ __forceinline__ unsigned grow(int, int) const { return 0u; }
};
struct MoeSched {
    const LAS int* ul; const LAS unsigned* tab; const char* A; const char* Bt; size_t tstepA, tstepB, estrideB;
    __device__ __forceinline__ bool next(int i, Unit& u) const {
        if (i >= 8) return false;
        const int ok = __builtin_amdgcn_readfirstlane(ul[i * 4 + 3]); if (!ok) return false;
        u.pm = __builtin_amdgcn_readfirstlane(ul[i * 4]); u.pn = __builtin_amdgcn_readfirstlane(ul[i * 4 + 1]); u.e = __builtin_amdgcn_readfirstlane(ul[i * 4 + 2]); return true;
    }
    __device__ __forceinline__ const char* a_base(const Unit& u) const { return A + (size_t)u.pm * tstepA; }
    __device__ __forceinline__ const char* b_base(const Unit& u) const { return Bt + (size_t)u.e * estrideB + (size_t)u.pn * tstepB; }
    __device__ __forceinline__ unsigned grow(int ui, int r) const { return tab[ui * 256 + r]; }
};
}


__device__ __forceinline__ int t5_bucket(int d) {
    if (d < 16) return d;
    return 16 + (d >= 22) + (d >= 30) + (d >= 40) + (d >= 54) + (d >= 73) + (d >= 99) + (d >= 134) + (d >= 182) + (d >= 246) + (d >= 332) + (d >= 450) + (d >= 609) + (d >= 825) + (d >= 1117) + (d >= 1513);
}
namespace att {
typedef __bf16 bf16x2_t __attribute__((ext_vector_type(2)));
typedef short s16x4 __attribute__((ext_vector_type(4)));
__device__ __forceinline__ unsigned cvtpk(float lo, float hi) { f32x2 v = {lo, hi}; bf16x2_t b = __builtin_convertvector(v, bf16x2_t); return __builtin_bit_cast(unsigned, b); }
__device__ __forceinline__ int crow(int r, int hi) { return (r & 3) + 8 * (r >> 2) + 4 * hi; }
__device__ __forceinline__ s16x4 vtr(LAS const unsigned char* p) { return __builtin_bit_cast(s16x4, __builtin_amdgcn_ds_read_tr16_b64_v4i16((LAS s16x4*)p)); }
constexpr int WL_BYTES = 16384;
__device__ __forceinline__ void glds16(const void* gsrc, unsigned lds_dst) { unsigned keep;
    asm volatile("s_mov_b32 %0, m0\n\ts_mov_b32 m0, %2\n\ts_nop 0\n\tglobal_load_lds_dwordx4 %1, off\n\ts_mov_b32 m0, %0" : "=&s"(keep) : "v"(gsrc), "s"(lds_dst) : "memory"); }
__device__ __forceinline__ void load_k(bf16x8 (&kn)[8], const bf16_t* kb, int t_first, int tstride, int lane) {
    const int r32 = lane & 31, hi = lane >> 5;
#pragma unroll
    for (int blk = 0; blk < 2; ++blk) { int tok = t_first + (r32 + 32 * blk) * tstride; tok = tok < 0 ? 0 : tok; const bf16_t* p = kb + (size_t)tok * NPROJ + 8 * hi;
#pragma unroll
        for (int d0 = 0; d0 < 4; ++d0) kn[blk * 4 + d0] = *(const bf16x8*)(p + 16 * d0); }
}
__device__ __forceinline__ void dma_v(unsigned vbuf_addr, const bf16_t* vb, int t_first, int tstride, int lane) {
#pragma unroll
    for (int kg = 0; kg < 4; ++kg) { int tok = t_first + (16 * kg + (lane >> 2)) * tstride; tok = tok < 0 ? 0 : tok; const bf16_t* p = vb + (size_t)tok * NPROJ + (lane & 3) * 8;
        glds16(p, (unsigned)__builtin_amdgcn_readfirstlane(vbuf_addr + kg * 1024)); glds16(p + 32, (unsigned)__builtin_amdgcn_readfirstlane(vbuf_addr + (4 + kg) * 1024)); }
}
__device__ __forceinline__ void dma_k(unsigned kbuf_addr, const bf16_t* kb, int t_first, int tstride, int lane) {
    const int r32 = lane & 31, hi = lane >> 5;
#pragma unroll
    for (int blk = 0; blk < 2; ++blk) { int tok = t_first + (r32 + 32 * blk) * tstride; tok = tok < 0 ? 0 : tok; const bf16_t* p = kb + (size_t)tok * NPROJ + 8 * hi;
#pragma unroll
        for (int d0 = 0; d0 < 4; ++d0) glds16(p + 16 * d0, (unsigned)__builtin_amdgcn_readfirstlane(kbuf_addr + (blk * 4 + d0) * 1024)); }
}
__device__ __forceinline__ void read_k(bf16x8 (&kf)[8], LAS const unsigned char* kbuf, int lane) {
#pragma unroll
    for (int i = 0; i < 8; ++i) kf[i] = *(LAS const bf16x8*)(kbuf + i * 1024 + lane * 16);
    asm volatile("s_waitcnt lgkmcnt(0)" ::: "memory");
}
#define ATT_WAIT_V(n) asm volatile("s_waitcnt vmcnt(" #n ")" ::: "memory")
__device__ __forceinline__ void qk_tile(f32x16& p0, f32x16& p1, const bf16x8 (&kf)[8], const bf16x8 (&qf)[4]) {
    p0 = (f32x16){}; p1 = (f32x16){};
#pragma unroll
    for (int d0 = 0; d0 < 4; ++d0) { p0 = __builtin_amdgcn_mfma_f32_32x32x16_bf16(kf[d0], qf[d0], p0, 0, 0, 0); p1 = __builtin_amdgcn_mfma_f32_32x32x16_bf16(kf[4 + d0], qf[d0], p1, 0, 0, 0); }
}
__device__ __forceinline__ void pv_tile(f32x16 (&o)[2], const f32x16& p0, const f32x16& p1, LAS const unsigned char* vt, int lane) {
    const int hi = lane >> 5;
    u32x4 pw[4];
    pw[0] = (u32x4){cvtpk(p0[0], p0[1]), cvtpk(p0[2], p0[3]), cvtpk(p0[4], p0[5]), cvtpk(p0[6], p0[7])};
    pw[1] = (u32x4){cvtpk(p0[8], p0[9]), cvtpk(p0[10], p0[11]), cvtpk(p0[12], p0[13]), cvtpk(p0[14], p0[15])};
    pw[2] = (u32x4){cvtpk(p1[0], p1[1]), cvtpk(p1[2], p1[3]), cvtpk(p1[4], p1[5]), cvtpk(p1[6], p1[7])};
    pw[3] = (u32x4){cvtpk(p1[8], p1[9]), cvtpk(p1[10], p1[11]), cvtpk(p1[12], p1[13]), cvtpk(p1[14], p1[15])};
    LAS const unsigned char* vp = vt + ((lane >> 4) & 1) * 32 + (lane & 3) * 8 + (4 * hi + ((lane & 15) >> 2)) * 64;
#pragma unroll
    for (int d0 = 0; d0 < 2; ++d0)
#pragma unroll
        for (int ks = 0; ks < 4; ++ks) {
            const s16x4 lo = vtr(vp + d0 * 4096 + ks * 1024), hh = vtr(vp + d0 * 4096 + ks * 1024 + 512);
            const bf16x8 vf = (bf16x8){lo[0], lo[1], lo[2], lo[3], hh[0], hh[1], hh[2], hh[3]};
            o[d0] = __builtin_amdgcn_mfma_f32_32x32x16_bf16(__builtin_bit_cast(bf16x8, pw[ks]), vf, o[d0], 0, 0, 0);
        }
}
__device__ __forceinline__ void epilogue(const f32x16 (&o)[2], float lq_val, LAS unsigned char* wl, LAS float* lq, const float* gain64, bf16_t* Yb, int ycol, int tok0, int tokstride, int lane) {
    const int r32 = lane & 31, hi = lane >> 5;
    LAS float* stg = (LAS float*)wl;
    ATT_WAIT_V(0);
#pragma unroll
    for (int d0 = 0; d0 < 2; ++d0)
#pragma unroll
        for (int r = 0; r < 16; ++r) stg[crow(r, hi) * 68 + 32 * d0 + r32] = o[d0][r];
    if (hi == 0) lq[r32] = lq_val;
    asm volatile("s_waitcnt lgkmcnt(0)" ::: "memory");
    const int row = lane >> 1, half = lane & 1;
    const float sc = lq[row];
    f32x4 v[8]; float ss = 0.f;
#pragma unroll
    for (int j = 0; j < 8; ++j) { v[j] = *(LAS const f32x4*)(wl + row * 272 + half * 128 + j * 16) * sc; ss += (v[j].x * v[j].x + v[j].y * v[j].y) + (v[j].z * v[j].z + v[j].w * v[j].w); }
    ss += __shfl_xor(ss, 1);
    const float rs = rsqrtf(ss * (1.f / 64.f) + 1e-6f);
    bf16_t* yp = Yb + (size_t)(tok0 + row * tokstride) * DM + ycol + half * 32;
    const float* gp = gain64 + half * 32;
#pragma unroll
    for (int j = 0; j < 4; ++j) {
        const f32x4 g0 = *(const f32x4*)(gp + 8 * j), g1 = *(const f32x4*)(gp + 8 * j + 4); const f32x4 a = v[2 * j] * rs * g0, c = v[2 * j + 1] * rs * g1;
        u32x4 w; w.x = cvtpk(a.x, a.y); w.y = cvtpk(a.z, a.w); w.z = cvtpk(c.x, c.y); w.w = cvtpk(c.z, c.w);
        *(u32x4*)(yp + 8 * j) = w;
    }
    asm volatile("s_waitcnt lgkmcnt(0)" ::: "memory");
}

__device__ __forceinline__ void sb_half(f32x16& p, float (&L)[16], int cbase, int lo_c, unsigned span) {
#pragma unroll
    for (int r = 0; r < 16; ++r) {
        const int c = cbase + (r & 3) + 8 * (r >> 2);
        const float z = ((unsigned)(c - lo_c) < span) ? p[r] : -1e30f;
        const float ez = __builtin_amdgcn_exp2f(-__builtin_fabsf(z)); const float lg = __builtin_amdgcn_logf(1.f + ez); const float sp = __builtin_fmaxf(z, 0.f) + lg;
        L[r] = -sp; p[r] = z - sp;
    }
}
__device__ __forceinline__ void sb_elem(f32x16& p0, f32x16& p1, float& R2, int hi, int lim, int lo) {
    float L0[16], L1[16];
    const int lo_c = lo - 4 * hi; const unsigned span = (unsigned)(lim - lo);
    sb_half(p0, L0, 0, lo_c, span); sb_half(p1, L1, 32, lo_c, span);
    float gs[8], ps[8], og[8];
#pragma unroll
    for (int k = 0; k < 4; ++k) { gs[k] = (L0[4 * k] + L0[4 * k + 1]) + (L0[4 * k + 2] + L0[4 * k + 3]); gs[4 + k] = (L1[4 * k] + L1[4 * k + 1]) + (L1[4 * k + 2] + L1[4 * k + 3]); }
#pragma unroll
    for (int k = 0; k < 8; ++k) { auto rr = __builtin_amdgcn_permlane32_swap(__float_as_uint(gs[k]), __float_as_uint(gs[k]), false, false);
        const float a = __uint_as_float(rr[0]), b = __uint_as_float(rr[1]); ps[k] = a + b; og[k] = hi ? 0.f : b; }
    float T[8]; float run = R2;
#pragma unroll
    for (int k = 7; k >= 0; --k) { T[k] = run + og[k]; run += ps[k]; }
    R2 = run;
#pragma unroll
    for (int k = 0; k < 4; ++k) {
        { float b = T[k]; p0[4 * k + 3] = __builtin_amdgcn_exp2f(p0[4 * k + 3] + b); b += L0[4 * k + 3]; p0[4 * k + 2] = __builtin_amdgcn_exp2f(p0[4 * k + 2] + b); b += L0[4 * k + 2];
          p0[4 * k + 1] = __builtin_amdgcn_exp2f(p0[4 * k + 1] + b); b += L0[4 * k + 1]; p0[4 * k] = __builtin_amdgcn_exp2f(p0[4 * k] + b); }
        { float b = T[4 + k]; p1[4 * k + 3] = __builtin_amdgcn_exp2f(p1[4 * k + 3] + b); b += L1[4 * k + 3]; p1[4 * k + 2] = __builtin_amdgcn_exp2f(p1[4 * k + 2] + b); b += L1[4 * k + 2];
          p1[4 * k + 1] = __builtin_amdgcn_exp2f(p1[4 * k + 1] + b); b += L1[4 * k + 1]; p1[4 * k] = __builtin_amdgcn_exp2f(p1[4 * k] + b); }
    }
}
__device__ __forceinline__ void sb_unit(const bf16_t* pb, int h, int q0, LAS unsigned char* wl, LAS float* wsc, const float* gain, bf16_t* Yb, int lane) {
    asm volatile("" : "+v"(lane));
    const int r32 = lane & 31, hi = lane >> 5;
    const unsigned wl_addr = (unsigned)(size_t)wl;
    bf16x8 qf[4];
    { const bf16_t* qp = pb + (size_t)(q0 + r32) * NPROJ + h * 64 + 8 * hi;
#pragma unroll
      for (int d0 = 0; d0 < 4; ++d0) qf[d0] = *(const bf16x8*)(qp + 16 * d0); }
    const bf16_t* kb = pb + 512 + h * 64; const bf16_t* vb = pb + 1024 + h * 64;
    const int nt = (q0 + 31) / 64 + 1;
    f32x16 o[2]; o[0] = (f32x16){}; o[1] = (f32x16){};
    float R2 = 0.f;
    asm volatile("s_waitcnt vmcnt(0)" ::: "memory");
    dma_k(wl_addr, kb, q0 - 32, 1, lane); dma_v(wl_addr + 8192, vb, q0 - 32, 1, lane);
#pragma unroll 1
    for (int j = 0; j < nt; ++j) {
        const int t_first = q0 - 32 - 64 * j; const bool more = (j + 1 < nt);
        ATT_WAIT_V(8);
        bf16x8 kf[8]; read_k(kf, wl, lane);
        if (more) dma_k(wl_addr, kb, t_first - 64, 1, lane);
        f32x16 p0, p1;
        qk_tile(p0, p1, kf, qf);
        sb_elem(p0, p1, R2, hi, (q0 + r32) - t_first, t_first < 0 ? -t_first : 0);
        if (more) ATT_WAIT_V(8); else ATT_WAIT_V(0);
        pv_tile(o, p0, p1, wl + 8192, lane);
        asm volatile("s_waitcnt lgkmcnt(0)" ::: "memory");
        if (__all(R2 < -150.f)) break;
        if (more) dma_v(wl_addr + 8192, vb, t_first - 64, 1, lane);
    }
    epilogue(o, 1.f, wl, wsc, gain + h * 64, Yb, h * 64, q0, 1, lane);
}
template <bool EARLY>
__device__ __forceinline__ void dil_scores(f32x16& p0, f32x16& p1, float& tmax, int sbl, int lo_c, LAS const float* tab) {
#pragma unroll
    for (int blk = 0; blk < 2; ++blk)
#pragma unroll
        for (int r = 0; r < 16; ++r) {
            const int c = 32 * blk + (r & 3) + 8 * (r >> 2); const unsigned st = (unsigned)(sbl - c); const unsigned idx = st < 129u ? st : 129u;
            const float bias = tab[idx]; const float z = blk ? p1[r] : p0[r]; float s = z + bias;
            if (EARLY) s = (c >= lo_c) ? s : -3e38f;
            if (blk) p1[r] = s; else p0[r] = s; tmax = __builtin_fmaxf(tmax, s);
        }
}
__device__ __forceinline__ void dil_elem(f32x16& p0, f32x16& p1, float& m, float& l, f32x16 (&o)[2], int sbl, int lo_c, bool early, LAS const float* tab, LAS float* wsf, int r32, int hi) {
    float tmax = -3e38f;
    if (early) dil_scores<true>(p0, p1, tmax, sbl, lo_c, tab); else dil_scores<false>(p0, p1, tmax, sbl, lo_c, tab);
    { auto rr = __builtin_amdgcn_permlane32_swap(__float_as_uint(tmax), __float_as_uint(tmax), false, false); tmax = __builtin_fmaxf(__uint_as_float(rr[0]), __uint_as_float(rr[1])); }
    const float mnew = __builtin_fmaxf(m, tmax);
    if (__any(mnew > m)) {
        const float f = __builtin_amdgcn_exp2f(m - mnew); l *= f;
        if (hi == 0) wsf[r32] = f;
        asm volatile("s_waitcnt lgkmcnt(0)" ::: "memory");
#pragma unroll
        for (int r = 0; r < 16; ++r) { const float fr = wsf[crow(r, hi)]; o[0][r] *= fr; o[1][r] *= fr; }
        asm volatile("s_waitcnt lgkmcnt(0)" ::: "memory");
    }
    m = mnew;
    float acc = 0.f;
#pragma unroll
    for (int r = 0; r < 16; ++r) { p0[r] = __builtin_amdgcn_exp2f(p0[r] - m); p1[r] = __builtin_amdgcn_exp2f(p1[r] - m); acc += p0[r] + p1[r]; }
    l += acc;
}
template <int STAGE> __device__ __forceinline__ void dil_params(int ti, int t0, int& t_first, int& tstride, int& br, int& pk  , int& kc0, int& qs) {
    int j, sh;
    if (STAGE == 1) { sh = 0; j = ti; qs = 1; br = 0; } else if (ti < 4) { sh = 2; j = ti; qs = 4; br = 1; } else { sh = 4; j = ti - 4; qs = 1; br = 2; }
    tstride = 1 << sh;
    const int r = t0 & (tstride - 1), P0 = t0 >> sh;
    kc0 = P0 + qs * 31 - 63 - 64 * j; pk = P0 - kc0; t_first = r + tstride * kc0;
}
template <int STAGE>
__device__ __forceinline__ void dil_pass(const bf16_t* pb, int h, int t0, LAS unsigned char* wl, LAS float* wsc, LAS const float* tab3, const float* gain, bf16_t* Yb, bf16_t* PO, float* PL, int lane) {
    asm volatile("" : "+v"(lane));
    const int r32 = lane & 31, hi = lane >> 5;
    const unsigned wl_addr = (unsigned)(size_t)wl;
    constexpr int QSTR = (STAGE == 1) ? 1 : 16, NTILE = (STAGE == 1) ? 3 : 7;
    bf16x8 qf[4];
    { const bf16_t* qp = pb + (size_t)(t0 + QSTR * r32) * NPROJ + 1536 + h * 64 + 8 * hi;
#pragma unroll
      for (int d0 = 0; d0 < 4; ++d0) qf[d0] = *(const bf16x8*)(qp + 16 * d0); }
    const bf16_t* kb = pb + 2048 + h * 64; const bf16_t* vb = pb + 2560 + h * 64;
    f32x16 o[2]; o[0] = (f32x16){}; o[1] = (f32x16){};
    float m = -1e30f, l = 0.f;
    int t_first, tstride, br, pk, kc0, qs;
    dil_params<STAGE>(0, t0, t_first, tstride, br, pk, kc0, qs);
    bf16x8 kn[8];
    load_k(kn, kb, t_first, tstride, lane); dma_v(wl_addr, vb, t_first, tstride, lane);
#pragma unroll 1
    for (int ti = 0; ti < NTILE; ++ti) {
        const int c_br = br, c_pk = pk, c_kc0 = kc0, c_qs = qs; const bool more = (ti + 1 < NTILE);
        ATT_WAIT_V(0);
        bf16x8 kf[8];
#pragma unroll
        for (int i = 0; i < 8; ++i) kf[i] = kn[i];
        if (more) { dil_params<STAGE>(ti + 1, t0, t_first, tstride, br, pk, kc0, qs); load_k(kn, kb, t_first, tstride, lane); dma_v(wl_addr + ((ti + 1) & 1) * 8192, vb, t_first, tstride, lane); }
        f32x16 p0, p1;
        qk_tile(p0, p1, kf, qf);
        dil_elem(p0, p1, m, l, o, c_pk + c_qs * r32 - 4 * hi, -c_kc0 - 4 * hi, c_kc0 < 0, tab3 + c_br * 130, wsc + 32, r32, hi);
        pv_tile(o, p0, p1, wl + (ti & 1) * 8192, lane);
        asm volatile("s_waitcnt lgkmcnt(0)" ::: "memory");
    }
    ATT_WAIT_V(0);
    { auto rr = __builtin_amdgcn_permlane32_swap(__float_as_uint(l), __float_as_uint(l), false, false); l = __uint_as_float(rr[0]) + __uint_as_float(rr[1]); }
    LAS float* stg = (LAS float*)wl;
#pragma unroll
    for (int d0 = 0; d0 < 2; ++d0)
#pragma unroll
        for (int r = 0; r < 16; ++r) stg[crow(r, hi) * 68 + 32 * d0 + r32] = o[d0][r];
    if (hi == 0) { wsc[r32] = l; wsc[32 + r32] = m; }
    asm volatile("s_waitcnt lgkmcnt(0)" ::: "memory");
    const int row = lane >> 1, half = lane & 1;
    const float lr = wsc[row], mr = wsc[32 + row];
    const int tok = t0 + QSTR * row;
    f32x4 v[8];
#pragma unroll
    for (int j = 0; j < 8; ++j) v[j] = *(LAS const f32x4*)(wl + row * 272 + half * 128 + j * 16);
    if (STAGE == 1) {
        const float il = 1.f / lr;
        bf16_t* pp = PO + (size_t)tok * 512 + h * 64 + half * 32;
#pragma unroll
        for (int j = 0; j < 4; ++j) { const f32x4 a = v[2 * j] * il, c = v[2 * j + 1] * il; u32x4 w; w.x = cvtpk(a.x, a.y); w.y = cvtpk(a.z, a.w); w.z = cvtpk(c.x, c.y); w.w = cvtpk(c.z, c.w); *(u32x4*)(pp + 8 * j) = w; }
        if (half == 0) PL[(size_t)tok * 8 + h] = mr + __builtin_amdgcn_logf(lr);
    } else {
        const float lse1 = PL[(size_t)tok * 8 + h];
        const bf16_t* pp = PO + (size_t)tok * 512 + h * 64 + half * 32;
        u32x4 pw[4];
#pragma unroll
        for (int j = 0; j < 4; ++j) pw[j] = *(const u32x4*)(pp + 8 * j);
        const float M = __builtin_fmaxf(lse1, mr); const float w1 = __builtin_amdgcn_exp2f(lse1 - M), w2 = __builtin_amdgcn_exp2f(mr - M); const float inv = 1.f / (w1 + lr * w2);
        const float c1 = w1 * inv, c2 = w2 * inv; float ss = 0.f;
#pragma unroll
        for (int j = 0; j < 4; ++j) {
            const f32x4 a1 = (f32x4){__uint_as_float(pw[j].x << 16), __uint_as_float(pw[j].x & 0xffff0000u), __uint_as_float(pw[j].y << 16), __uint_as_float(pw[j].y & 0xffff0000u)};
            const f32x4 b1 = (f32x4){__uint_as_float(pw[j].z << 16), __uint_as_float(pw[j].z & 0xffff0000u), __uint_as_float(pw[j].w << 16), __uint_as_float(pw[j].w & 0xffff0000u)};
            v[2 * j] = a1 * c1 + v[2 * j] * c2; v[2 * j + 1] = b1 * c1 + v[2 * j + 1] * c2;
            ss += (v[2 * j].x * v[2 * j].x + v[2 * j].y * v[2 * j].y) + (v[2 * j].z * v[2 * j].z + v[2 * j].w * v[2 * j].w);
            ss += (v[2 * j + 1].x * v[2 * j + 1].x + v[2 * j + 1].y * v[2 * j + 1].y) + (v[2 * j + 1].z * v[2 * j + 1].z + v[2 * j + 1].w * v[2 * j + 1].w);
        }
        ss += __shfl_xor(ss, 1);
        const float rs = rsqrtf(ss * (1.f / 64.f) + 1e-6f);
        bf16_t* yp = Yb + (size_t)tok * DM + 512 + h * 64 + half * 32;
        const float* gp = gain + h * 64 + half * 32;
#pragma unroll
        for (int j = 0; j < 4; ++j) {
            const f32x4 g0 = *(const f32x4*)(gp + 8 * j), g1 = *(const f32x4*)(gp + 8 * j + 4); const f32x4 a = v[2 * j] * rs * g0, c = v[2 * j + 1] * rs * g1;
            u32x4 w; w.x = cvtpk(a.x, a.y); w.y = cvtpk(a.z, a.w); w.z = cvtpk(c.x, c.y); w.w = cvtpk(c.z, c.w);
            *(u32x4*)(yp + 8 * j) = w;
        }
    }
    asm volatile("s_waitcnt lgkmcnt(0)" ::: "memory");
}
}

#define XB_TMO      128
#define XB_XCNT(j)  (256  + 64 * (j))
#define XB_XSUB(j)  (1280 + 64 * (j))
#define XB_XGEN(j)  (2304 + 64 * (j))
#define XB_TOP      3328
#define XB_TOPGEN   3392
#define XCD_BAR_WORDS 3456
#define XB_SPIN_CAP (1u << 18)
__device__ __forceinline__ unsigned xb_ld(unsigned* p)              { return __hip_atomic_load(p, __ATOMIC_RELAXED, __HIP_MEMORY_SCOPE_AGENT); }
__device__ __forceinline__ unsigned xb_add(unsigned* p, unsigned v) { return __hip_atomic_fetch_add(p, v, __ATOMIC_RELAXED, __HIP_MEMORY_SCOPE_AGENT); }
__device__ __forceinline__ unsigned xb_xcc_id() { return (unsigned)__builtin_amdgcn_s_getreg((3 << 11) | 20) & 0xFu; }
#define XB_SPIN(cond, bar) do { unsigned _sp = 0; while (cond) { __builtin_amdgcn_s_sleep(1); \
    if ((++_sp & 255u) == 0u) { if (xb_ld(&(bar)[XB_TMO])) break; if (_sp > XB_SPIN_CAP) { atomicAdd(&(bar)[XB_TMO], 1u); break; } } } } while (0)
struct XcdBarrier { unsigned* bar; unsigned x; volatile LAS unsigned* st; };
__device__ __forceinline__ XcdBarrier xcd_barrier_post(unsigned* bar, volatile LAS unsigned* st) {
    XcdBarrier b; b.bar = bar; b.x = xb_xcc_id(); b.st = st;
    if (threadIdx.x == 0) (void)xb_add(&bar[XB_XCNT(b.x)], 1u);
    return b;
}
__device__ __forceinline__ void xcd_barrier_complete(unsigned* bar, unsigned x, unsigned& nloc, unsigned& nx) {
    const unsigned G = gridDim.x * gridDim.y * gridDim.z;
    unsigned sum, cnt, mine, sp = 0u;
    for (;;) {
        sum = 0u; cnt = 0u; mine = 0u;
#pragma unroll
        for (unsigned j = 0; j < 16; ++j) { const unsigned c = xb_ld(&bar[XB_XCNT(j)]); sum += c; cnt += (c > 0u) ? 1u : 0u; mine = (j == x) ? c : mine; }
        if (sum == G) break;
        __builtin_amdgcn_s_sleep(1);
        if ((++sp & 255u) == 0u) { if (xb_ld(&bar[XB_TMO])) break; if (sp > XB_SPIN_CAP) { atomicAdd(&bar[XB_TMO], 1u); break; } }
    }
    nloc = mine > 0u ? mine : 1u; nx = cnt > 0u ? cnt : 1u;
}
__device__ __forceinline__ void xcd_barrier(const XcdBarrier& b) {
    asm volatile("s_waitcnt vmcnt(0)" ::: "memory");
    __syncthreads();
    if (threadIdx.x == 0) {
        unsigned* bar = b.bar;
        __builtin_amdgcn_s_waitcnt(0);
        unsigned nloc = b.st[0], nx = b.st[1];
        if (nloc == 0u) { xcd_barrier_complete(bar, b.x, nloc, nx); b.st[0] = nloc; b.st[1] = nx; }
        const unsigned old = xb_add(&bar[XB_XSUB(b.x)], 1u);
        const unsigned gen = old / nloc;
        if (old + 1u == (gen + 1u) * nloc) {
            __builtin_amdgcn_fence(__ATOMIC_RELEASE, "agent");
            asm volatile("s_waitcnt vmcnt(0)" ::: "memory");
            const unsigned og = xb_add(&bar[XB_TOP], 1u);
            const unsigned tg = og / nx;
            if (og + 1u == (tg + 1u) * nx) xb_add(&bar[XB_TOPGEN], 1u);
            else XB_SPIN(xb_ld(&bar[XB_TOPGEN]) == tg, bar);
            __builtin_amdgcn_fence(__ATOMIC_ACQUIRE, "agent");
            xb_add(&bar[XB_XGEN(b.x)], 1u);
            asm volatile("s_waitcnt vmcnt(0)" ::: "memory");
        } else {
            XB_SPIN(xb_ld(&bar[XB_XGEN(b.x)]) == gen, bar);
            __builtin_amdgcn_fence(__ATOMIC_ACQUIRE, "agent");
            asm volatile("s_waitcnt vmcnt(0)" ::: "memory");
        }
    }
    __syncthreads();
}

constexpr int NWAVES = 8;
constexpr int RING_BYTES = 131072;
constexpr int TAB_OFF = RING_BYTES;
constexpr int PB_OFF = TAB_OFF + 8192;
constexpr int MISC_OFF = PB_OFF + 512;
constexpr int WSC_OFF = MISC_OFF + 256;
constexpr int TS_OFF = WSC_OFF + 2048;
constexpr int LDS_BYTES = 147456;
static_assert(WSC_OFF + 2048 <= LDS_BYTES, "LDS map");
constexpr int PH_PER_LAYER = 8, N_PHASES = DEPTH * PH_PER_LAYER;
enum { PH_W = 0, PH_QKV = 1, PH_ATT = 2, PH_OUT = 3, PH_LNR = 4, PH_MOE1 = 5, PH_MOE2 = 6, PH_COMB = 7 };

struct Args { const float* in[15]; float* out; unsigned char* ws; int ph_lo, ph_hi; };

__device__ __forceinline__ float wave_sum(float v) {
#pragma unroll
    for (int o = 1; o < 64; o <<= 1) v += __shfl_xor(v, o);
    return v;
}
struct ConvDesc { const float* src; bf16_t* dst; int N, K; };
__device__ __forceinline__ void conv_load(f32x4 (&v)[8], const ConvDesc& d, int lane) {
    const unsigned loff = (unsigned)((lane >> 3) * d.N + (lane & 7) * 4) * 4u;
#pragma unroll
    for (int i = 0; i < 8; ++i) v[i] = *(const f32x4*)((const char*)(d.src + (size_t)(i * 8) * d.N) + loff);
}
__device__ __forceinline__ void conv_store(const f32x4 (&v)[8], const ConvDesc& d, LAS float* scr, int lane) {
#pragma unroll
    for (int i = 0; i < 8; ++i) { LAS float* q = scr + (i * 8 + (lane >> 3)) * 33 + (lane & 7) * 4; q[0] = v[i].x; q[1] = v[i].y; q[2] = v[i].z; q[3] = v[i].w; }
    asm volatile("s_waitcnt lgkmcnt(0)" ::: "memory");
    const int c = lane & 7;
#pragma unroll
    for (int j = 0; j < 4; ++j) { const int n = (lane >> 3) + 8 * j; const LAS float* sp = scr + (8 * c) * 33 + n;
        u32x4 o; o.x = pk2(sp[0 * 33], sp[1 * 33]); o.y = pk2(sp[2 * 33], sp[3 * 33]); o.z = pk2(sp[4 * 33], sp[5 * 33]); o.w = pk2(sp[6 * 33], sp[7 * 33]);
        *(u32x4*)(d.dst + (size_t)n * d.K + 8 * c) = o; }
    asm volatile("s_waitcnt lgkmcnt(0)" ::: "memory");
}
__device__ __forceinline__ ConvDesc conv_mk(const float* W, int K, int N, bf16_t* WT, int row_off, int kb, int nb) {
    ConvDesc d; d.src = W + (size_t)(64 * kb) * N + 32 * nb; d.dst = WT + (size_t)(row_off + 32 * nb) * K + 64 * kb; d.N = N; d.K = K; return d;
}
constexpr int CI_SQ = 16 * 32, CI_IN = 16 * 96, CI_BASE = CI_SQ + 48 * CI_SQ;
__device__ __forceinline__ ConvDesc conv_desc(int it, int l, const float* w_in, const float* w_out, const float* w_gate, const float* w_up, const float* w_down,
                                              bf16_t* Win_t, bf16_t* Wout_t, bf16_t* Wgu_t, bf16_t* Wd_t) {
    int r = it;
    if (r < CI_SQ) return conv_mk(w_out + (size_t)l * DM * DM, DM, DM, Wout_t, 0, r / 32, r % 32);
    r -= CI_SQ;
    if (r < 48 * CI_SQ) {
        const int mtx = r / CI_SQ, e = mtx / 3, kind = mtx % 3, rr = r % CI_SQ, kb = rr / 32, nb = rr % 32;
        const size_t eoff = ((size_t)l * NEXP + e) * DM * FF;
        if (kind == 2) return conv_mk(w_down + eoff, FF, DM, Wd_t + (size_t)e * DM * FF, 0, kb, nb);
        return conv_mk((kind == 0 ? w_gate : w_up) + eoff, DM, FF, Wgu_t + (size_t)e * 2 * FF * DM, (nb >> 2) * 128 + kind * 128, kb, nb);
    }
    r -= 48 * CI_SQ;
    return conv_mk(w_in + (size_t)(l + 1) * DM * NPROJ, DM, NPROJ, Win_t + (size_t)(l + 1) * NPROJ * DM, 0, r / 96, r % 96);
}
__global__ void __launch_bounds__(NWAVES * 64, 2) mk(Args args) {
    extern __shared__ __attribute__((aligned(16))) unsigned char lds_raw[];
    LAS unsigned char* lds = (LAS unsigned char*)lds_raw;
    volatile LAS unsigned* MISC = (volatile LAS unsigned*)(lds + MISC_OFF);
    const int tid = threadIdx.x, lane = tid & 63, wave = __builtin_amdgcn_readfirstlane(tid >> 6);
    const int G = gridDim.x; const int bx = blockIdx.x; const int vcu = (G % 8 == 0) ? (bx % 8) * (G / 8) + bx / 8 : bx;
    unsigned char* ws = args.ws;
    unsigned* ctl = (unsigned*)(ws + WS_CTL);
    for (int u = tid; u < 32; u += NWAVES * 64) MISC[u] = 0u;
    __syncthreads();
    const bool multi = (args.ph_hi - args.ph_lo) > 1;
    XcdBarrier bar; bar.bar = ctl + CW_BAR; bar.x = 0; bar.st = nullptr;
    if (multi) bar = xcd_barrier_post(ctl + CW_BAR, MISC + 8);

    const float* x_in = args.in[0]; const float* w_in = args.in[1]; const float* w_out = args.in[4];
    const float* w_gate = args.in[12]; const float* w_up = args.in[13]; const float* w_down = args.in[14];
    bf16_t* Win_t = (bf16_t*)(ws + WS_WIN); bf16_t* Wout_t = (bf16_t*)(ws + WS_WOUT); bf16_t* Wgu_t = (bf16_t*)(ws + WS_WGU); bf16_t* Wd_t = (bf16_t*)(ws + WS_WD);
    bf16_t* XB = (bf16_t*)(ws + WS_XB); bf16_t* PROJ = (bf16_t*)(ws + WS_PROJ); bf16_t* HB = (bf16_t*)(ws + WS_H);
    bf16_t* Y = (bf16_t*)(ws + WS_Y); bf16_t* T = (bf16_t*)(ws + WS_T); bf16_t* YP = (bf16_t*)(ws + WS_YP); bf16_t* X1B = (bf16_t*)(ws + WS_X1B);
    const int* perm = (const int*)(ws + WS_PERM);

#define IN(k) (args.ph_lo <= (k) && (k) < args.ph_hi)
#if PROBE_M >= 0
#define PROBE_SPIN(k) do { if (threadIdx.x == 0) { volatile LAS unsigned long long* tsp = (volatile LAS unsigned long long*)(lds + TS_OFF); const unsigned long long now = wall_clock64(); \
        if ((((k) & 7) == PROBE_M)) { const unsigned long long span = now - tsp[0]; while (wall_clock64() - now < 3ull * span) __builtin_amdgcn_s_sleep(8); } tsp[0] = wall_clock64(); } __syncthreads(); } while (0)
#else
#define PROBE_SPIN(k) do { } while (0)
#endif
#define SEAM(k) do { if (IN(k) && IN((k) + 1)) { xcd_barrier(bar); PROBE_SPIN(k); } } while (0)
#if PROBE_M >= 0
    if (threadIdx.x == 0) ((volatile LAS unsigned long long*)(lds + TS_OFF))[0] = wall_clock64();
    __syncthreads();
#endif
    for (int l = 0; l < DEPTH; ++l) {
        const int pbase = l * PH_PER_LAYER;
        if (l == 0 && IN(pbase + PH_W)) REPS(PH_W) {
            int tl = threadIdx.x; asm volatile("" : "+v"(tl)); const int lane = tl & 63, wave = __builtin_amdgcn_readfirstlane(tl >> 6);
            LAS float* scr = (LAS float*)(lds + wave * 16384);
            const int gw = vcu * NWAVES + wave, NGW = G * NWAVES;
            for (int it = gw; it < CI_IN; it += NGW) { const ConvDesc d = conv_mk(w_in, DM, NPROJ, Win_t, 0, it / 96, it % 96); f32x4 v[8]; conv_load(v, d, lane); conv_store(v, d, scr, lane); }
            for (int m = gw; m < NTOK; m += NGW) {
                const f32x4* xr = (const f32x4*)(x_in + (size_t)m * DM) + lane; unsigned long long* o8 = (unsigned long long*)(XB + (size_t)m * DM) + lane;
#pragma unroll
                for (int j = 0; j < 4; ++j) { const f32x4 v = xr[64 * j]; o8[64 * j] = (unsigned long long)pk2(v.x, v.y) | ((unsigned long long)pk2(v.z, v.w) << 32); }
            }
            __syncthreads();
        }
        if (l == 0) SEAM(pbase + PH_W);
        if (IN(pbase + PH_QKV)) REPS(PH_QKV) {
            pg8::DenseSched S; S.init(NTOK, NPROJ, DM, G, bx, XB, Win_t + (size_t)l * NPROJ * DM);
            pg8::EpiProj E{PROJ};
            pg8::gemm_phase<pg8::EpiProj, pg8::DenseSched, false, true>(lds, DM, S, E);
        }
        SEAM(pbase + PH_QKV);
        if (IN(pbase + PH_ATT)) REPS(PH_ATT) {
            int tl = threadIdx.x; asm volatile("" : "+v"(tl)); const int lane = tl & 63, wave = __builtin_amdgcn_readfirstlane(tl >> 6);
            LAS unsigned char* wl = lds + wave * att::WL_BYTES;
            LAS float* tab = (LAS float*)(lds + TAB_OFF);
            LAS float* wsc = (LAS float*)(lds + WSC_OFF + wave * 256);
            const float* g_sb = args.in[2] + l * 512; const float* g_dil = args.in[3] + l * 512; const float* rel_bias = args.in[9];
            bf16_t* PO = (bf16_t*)(ws + WS_T); float* PL = (float*)(ws + WS_T + 16 * MiB);
            for (int wu = vcu; wu < 256; wu += G) {
                const int b = wu >> 7, h = (wu >> 4) & 7, blk = wu & 15;
                const bf16_t* pb = PROJ + (size_t)b * SEQ * NPROJ; bf16_t* Yb = Y + (size_t)b * SEQ * DM;
                __syncthreads();
                if (tl < 3 * 130) { const int br = tl / 130, st = tl % 130; tab[tl] = (st < 129) ? rel_bias[t5_bucket(st << (2 * br)) * 8 + h] * LOG2E : -3e38f; }
                __syncthreads();
                const int n_items = CI_BASE + (l == 0 ? CI_IN : 0); const bool cfirst = wave >= 4;
                int cit = wu * NWAVES + wave; LAS float* scr = (LAS float*)wl;
#define CONV_TRIP() do { if (cit < n_items) { const int it1 = cit + 256 * NWAVES; const bool has1 = it1 < n_items; \
                    const ConvDesc d0 = conv_desc(cit, l, w_in, w_out, w_gate, w_up, w_down, Win_t, Wout_t, Wgu_t, Wd_t); \
                    const ConvDesc d1 = conv_desc(has1 ? it1 : cit, l, w_in, w_out, w_gate, w_up, w_down, Win_t, Wout_t, Wgu_t, Wd_t); \
                    f32x4 v0[8], v1[8]; conv_load(v0, d0, lane); conv_load(v1, d1, lane); conv_store(v0, d0, scr, lane); if (has1) conv_store(v1, d1, scr, lane); \
                    cit += 2 * 256 * NWAVES; } } while (0)
#pragma unroll 1
                for (int k = 0; k < 3; ++k) {
                    if (cfirst ? (k < 2) : (k > 0)) CONV_TRIP();
                    if (k < 2) att::dil_pass<1>(pb, h, blk * 512 + (k * 8 + wave) * 32, wl, wsc, tab, g_dil, Yb, PO + (size_t)b * SEQ * 512, PL + (size_t)b * SEQ * 8, lane);
                }
                asm volatile("s_waitcnt vmcnt(0)" ::: "memory");
                __syncthreads();
                __builtin_amdgcn_fence(__ATOMIC_ACQUIRE, "agent");
                asm volatile("s_waitcnt vmcnt(0)" ::: "memory");
#pragma unroll 1
                for (int k = 0; k < 3; ++k) {
                    if (cfirst ? (k < 2) : (k > 0)) CONV_TRIP();
                    if (k < 2) att::sb_unit(pb, h, blk * 512 + (k * 8 + wave) * 32, wl, wsc, g_sb, Yb, lane);
                }
#pragma unroll 1
                for (int k = 0; k < 3; ++k) {
                    if (cfirst ? (k < 2) : (k > 0)) CONV_TRIP();
                    if (k < 2) att::dil_pass<2>(pb, h, blk * 512 + k * 8 + wave, wl, wsc, tab, g_dil, Yb, PO + (size_t)b * SEQ * 512, PL + (size_t)b * SEQ * 8, lane);
                }
#pragma unroll 1
                while (cit < n_items) CONV_TRIP();
#undef CONV_TRIP
            }
            __syncthreads();
        }
        SEAM(pbase + PH_ATT);
        if (IN(pbase + PH_OUT)) REPS(PH_OUT) {
            pg8::DenseSched S; S.init(NTOK, DM, DM, G, bx, Y, Wout_t);
            if (l == 0) { pg8::EpiRes<true> E{x_in, XB, T}; pg8::gemm_phase<pg8::EpiRes<true>, pg8::DenseSched, false, false>(lds, DM, S, E); }
            else { pg8::EpiRes<false> E{x_in, XB, T}; pg8::gemm_phase<pg8::EpiRes<false>, pg8::DenseSched, false, false>(lds, DM, S, E); }
        }
        SEAM(pbase + PH_OUT);
        if (IN(pbase + PH_LNR)) {
            int tl = threadIdx.x; asm volatile("" : "+v"(tl)); const int lane = tl & 63, wave = __builtin_amdgcn_readfirstlane(tl >> 6);
            LAS float* wrt = (LAS float*)lds;
            LAS float* lgt = (LAS float*)(lds + 65536);
            const float* w_router = args.in[10]; const float* b_router = args.in[11];
            const float* lg = args.in[5] + l * DM; const float* lb = args.in[6] + l * DM;
            unsigned* cnt = ctl + CW_CNT + l * 1024; int* permw = (int*)(ws + WS_PERM); TokInfo* info = (TokInfo*)(ws + WS_INFO);
            __syncthreads();
            for (int i = tl; i < 16 * DM; i += NWAVES * 64) wrt[(i & 15) * DM + (i >> 4)] = w_router[i];
            __syncthreads();
            for (int wu = vcu; wu < NTOK / 64; wu += G) {
#pragma unroll 1
                for (int bt = 0; bt < 2; ++bt) {
                    const int lt0 = wave * 8 + bt * 4, tok0 = wu * 64 + lt0;
                    f32x4 v[4][4]; float s[4], s2[4];
#pragma unroll
                    for (int t = 0; t < 4; ++t) { const u32x2* xr = (const u32x2*)(T + (size_t)(tok0 + t) * DM) + lane;
#pragma unroll
                        for (int j = 0; j < 4; ++j) { const u32x2 w = xr[64 * j]; v[t][j] = (f32x4){__uint_as_float(w.x << 16), __uint_as_float(w.x & 0xffff0000u), __uint_as_float(w.y << 16), __uint_as_float(w.y & 0xffff0000u)}; } }
#pragma unroll
                    for (int t = 0; t < 4; ++t) { s[t] = 0.f;
#pragma unroll
                        for (int j = 0; j < 4; ++j) s[t] += (v[t][j].x + v[t][j].y) + (v[t][j].z + v[t][j].w); }
#pragma unroll
                    for (int o = 1; o < 64; o <<= 1) {
#pragma unroll
                        for (int t = 0; t < 4; ++t) s[t] += __shfl_xor(s[t], o); }
#pragma unroll
                    for (int t = 0; t < 4; ++t) { const float mean = s[t] * (1.f / DM); s2[t] = 0.f;
#pragma unroll
                        for (int j = 0; j < 4; ++j) { v[t][j] = v[t][j] - mean; s2[t] += (v[t][j].x * v[t][j].x + v[t][j].y * v[t][j].y) + (v[t][j].z * v[t][j].z + v[t][j].w * v[t][j].w); } }
#pragma unroll
                    for (int o = 1; o < 64; o <<= 1) {
#pragma unroll
                        for (int t = 0; t < 4; ++t) s2[t] += __shfl_xor(s2[t], o); }
#pragma unroll
                    for (int j = 0; j < 4; ++j) { const f32x4 gv = ((const f32x4*)lg)[lane + 64 * j], bv = ((const f32x4*)lb)[lane + 64 * j];
#pragma unroll
                        for (int t = 0; t < 4; ++t) { const float rstd = rsqrtf(s2[t] * (1.f / DM) + LN_EPS);
                            v[t][j] = v[t][j] * rstd * gv + bv;
                            ((unsigned long long*)(X1B + (size_t)(tok0 + t) * DM) + lane)[64 * j] = (unsigned long long)pk2(v[t][j].x, v[t][j].y) | ((unsigned long long)pk2(v[t][j].z, v[t][j].w) << 32); } }
                    float acc[64];
#pragma unroll
                    for (int e = 0; e < 16; ++e) {
                        float a0 = 0.f, a1 = 0.f, a2 = 0.f, a3 = 0.f;
#pragma unroll
                        for (int j = 0; j < 4; ++j) { const f32x4 w = *(const LAS f32x4*)(wrt + e * DM + 256 * j + 4 * lane);
                            a0 += (v[0][j].x * w.x + v[0][j].y * w.y) + (v[0][j].z * w.z + v[0][j].w * w.w); a1 += (v[1][j].x * w.x + v[1][j].y * w.y) + (v[1][j].z * w.z + v[1][j].w * w.w);
                            a2 += (v[2][j].x * w.x + v[2][j].y * w.y) + (v[2][j].z * w.z + v[2][j].w * w.w); a3 += (v[3][j].x * w.x + v[3][j].y * w.y) + (v[3][j].z * w.z + v[3][j].w * w.w); }
                        acc[e] = a0; acc[16 + e] = a1; acc[32 + e] = a2; acc[48 + e] = a3;
                    }
#define BFLY(N, M) { const bool up = (lane & (M)) != 0; _Pragma("unroll") for (int k = 0; k < (N); ++k) { const float snd = up ? acc[k] : acc[k + (N)]; const float kp = up ? acc[k + (N)] : acc[k]; acc[k] = kp + __shfl_xor(snd, (M)); } }
                    BFLY(32, 32) BFLY(16, 16) BFLY(8, 8) BFLY(4, 4) BFLY(2, 2) BFLY(1, 1)
#undef BFLY
                    lgt[lt0 * 16 + lane] = acc[0] + b_router[lane & 15];
                }
                __syncthreads();
                if (wave == 0) {
                    const f32x4 q0 = *(const LAS f32x4*)(lgt + lane * 16), q1 = *(const LAS f32x4*)(lgt + lane * 16 + 4), q2 = *(const LAS f32x4*)(lgt + lane * 16 + 8), q3 = *(const LAS f32x4*)(lgt + lane * 16 + 12);
                    const float lv[16] = {q0.x, q0.y, q0.z, q0.w, q1.x, q1.y, q1.z, q1.w, q2.x, q2.y, q2.z, q2.w, q3.x, q3.y, q3.z, q3.w};
                    float mx = lv[0];
#pragma unroll
                    for (int e = 1; e < 16; ++e) mx = fmaxf(mx, lv[e]);
                    float best = -1.f; int e1 = 0, e2 = 0; float bv1 = 0.f, bv2 = 0.f;
#pragma unroll
                    for (int gI = 0; gI < 4; ++gI) {
                        float v1 = -1.f, v2 = -1.f; int i1 = 0, i2 = 0;
#pragma unroll
                        for (int j = 0; j < 4; ++j) { const float pv = expf(lv[gI * 4 + j] - mx);
                            if (pv > v1) { v2 = v1; i2 = i1; v1 = pv; i1 = j; } else if (pv > v2) { v2 = pv; i2 = j; } }
                        const float sm = v1 + v2;
                        if (sm > best) { best = sm; e1 = gI * 4 + i1; e2 = gI * 4 + i2; bv1 = v1; bv2 = v2; }
                    }
                    const unsigned long long lt_mask = (1ull << lane) - 1ull;
                    int r1 = 0, r2 = 0, myn = 0;
#pragma unroll
                    for (int e = 0; e < 16; ++e) { const unsigned long long m1 = __ballot(e1 == e), m2 = __ballot(e2 == e);
                        const int before = __popcll(m1 & lt_mask) + __popcll(m2 & lt_mask);
                        if (e1 == e) r1 = before; if (e2 == e) r2 = before; if (lane == e) myn = __popcll(m1) + __popcll(m2); }
                    int base = 0;
                    if (lane < 16 && myn > 0) base = (int)__hip_atomic_fetch_add(cnt + 64 * lane, (unsigned)myn, __ATOMIC_RELAXED, __HIP_MEMORY_SCOPE_AGENT);
                    const int s1 = __shfl(base, e1) + r1, sl2 = __shfl(base, e2) + r2; const int tok = wu * 64 + lane;
                    permw[e1 * NTOK + s1] = tok; permw[e2 * NTOK + sl2] = tok;
                    TokInfo ti; ti.e1 = e1; ti.e2 = e2; ti.s1 = s1; ti.s2 = sl2; ti.g1 = bv1 / (bv1 + bv2); ti.g2 = bv2 / (bv1 + bv2); ti.pad0 = 0; ti.pad1 = 0;
                    info[tok] = ti;
                }
                __syncthreads();
            }
        }
        SEAM(pbase + PH_LNR);
        if (IN(pbase + PH_MOE1) || IN(pbase + PH_MOE2)) {
            int tid = threadIdx.x; asm volatile("" : "+v"(tid));
            LAS int* pb = (LAS int*)(lds + PB_OFF); LAS int* ul = pb + 32; LAS unsigned* tab = (LAS unsigned*)(lds + TAB_OFF);
            const int* cnt = (const int*)(ctl + CW_CNT + l * 1024);
            __syncthreads();
            if (tid == 0) { int sacc = 0; for (int e = 0; e < 16; ++e) { pb[e] = sacc; sacc += (cnt[64 * e] + 255) >> 8; } pb[16] = sacc; }
            __syncthreads();
#define MOE_ULIST(NT) do { if (tid < 8) { const int L = tid * G + vcu; const int okv = L < pb[16] * (NT); const int p = okv ? L / (NT) : 0; int e = 0; \
                for (int j = 1; j < 16; ++j) e += (pb[j] <= p) ? 1 : 0; ul[tid * 4] = p; ul[tid * 4 + 1] = L % (NT); ul[tid * 4 + 2] = e; ul[tid * 4 + 3] = okv; } __syncthreads(); } while (0)
            if (IN(pbase + PH_MOE1)) REPS(PH_MOE1) {
                MOE_ULIST(8);
#pragma unroll 1
                for (int i = 0; i < 8; ++i) {
                    if (ul[i * 4 + 3] && tid < 256) { const int e = ul[i * 4 + 2]; const int slot = (ul[i * 4] - pb[e]) * 256 + tid; const int c = cnt[64 * e]; const int tok = perm[e * NTOK + (slot < c ? slot : 0)]; tab[i * 256 + tid] = (unsigned)tok * (unsigned)(DM * 2); }
                }
                __syncthreads();
                pg8::MoeSched S{ul, tab, (const char*)X1B, (const char*)Wgu_t, 0, (size_t)256 * DM * 2, (size_t)2 * FF * DM * 2};
                pg8::EpiSwiGLU E{HB};
                pg8::gemm_phase<pg8::EpiSwiGLU, pg8::MoeSched, true, true>(lds, DM, S, E);
            }
            SEAM(pbase + PH_MOE1);
            if (IN(pbase + PH_MOE2)) REPS(PH_MOE2) {
                MOE_ULIST(4);
                pg8::MoeSched S{ul, tab, (const char*)HB, (const char*)Wd_t, (size_t)256 * FF * 2, (size_t)256 * FF * 2, (size_t)DM * FF * 2};
                pg8::EpiPlain E{YP, DM};
                pg8::gemm_phase<pg8::EpiPlain, pg8::MoeSched, false, true>(lds, FF, S, E);
            }
#undef MOE_ULIST
        }
        SEAM(pbase + PH_MOE2);
        if (IN(pbase + PH_COMB)) REPS(PH_COMB) {
            int tl = threadIdx.x; asm volatile("" : "+v"(tl)); const int lane = tl & 63, wave = __builtin_amdgcn_readfirstlane(tl >> 6);
            LAS int* pb = (LAS int*)(lds + PB_OFF);
            const int* cnt = (const int*)(ctl + CW_CNT + l * 1024);
            __syncthreads();
            if (tl == 0) { int sacc = 0; for (int e = 0; e < 16; ++e) { pb[e] = sacc; sacc += (cnt[64 * e] + 255) >> 8; } pb[16] = sacc; }
            __syncthreads();
            const TokInfo* info = (const TokInfo*)(ws + WS_INFO);
            const float* lg = args.in[7] + l * DM; const float* lb = args.in[8] + l * DM;
            const bool lastl = (l == DEPTH - 1);
            const int gw = vcu * NWAVES + wave, NGW = G * NWAVES;
            for (int tok = gw; tok < NTOK; tok += NGW) {
                const TokInfo ti = info[tok];
                const u32x2* xr = (const u32x2*)(X1B + (size_t)tok * DM) + lane;
                const u32x2* y1 = (const u32x2*)(YP + (size_t)(pb[ti.e1] * 256 + ti.s1) * DM) + lane;
                const u32x2* y2 = (const u32x2*)(YP + (size_t)(pb[ti.e2] * 256 + ti.s2) * DM) + lane;
                f32x4 v[4]; float s = 0.f;
#pragma unroll
                for (int j = 0; j < 4; ++j) { const u32x2 xw = xr[64 * j]; const f32x4 x = (f32x4){__uint_as_float(xw.x << 16), __uint_as_float(xw.x & 0xffff0000u), __uint_as_float(xw.y << 16), __uint_as_float(xw.y & 0xffff0000u)}; const u32x2 a = y1[64 * j], c = y2[64 * j];
                    const f32x4 ya = (f32x4){__uint_as_float(a.x << 16), __uint_as_float(a.x & 0xffff0000u), __uint_as_float(a.y << 16), __uint_as_float(a.y & 0xffff0000u)};
                    const f32x4 yc = (f32x4){__uint_as_float(c.x << 16), __uint_as_float(c.x & 0xffff0000u), __uint_as_float(c.y << 16), __uint_as_float(c.y & 0xffff0000u)};
                    v[j] = x * ALPHA + (ya * ti.g1 + yc * ti.g2); s += (v[j].x + v[j].y) + (v[j].z + v[j].w); }
                const float mean = wave_sum(s) * (1.f / DM); float s2 = 0.f;
#pragma unroll
                for (int j = 0; j < 4; ++j) { v[j] = v[j] - mean; s2 += (v[j].x * v[j].x + v[j].y * v[j].y) + (v[j].z * v[j].z + v[j].w * v[j].w); }
                const float rstd = rsqrtf(wave_sum(s2) * (1.f / DM) + LN_EPS);
                f32x4* o4 = (f32x4*)(args.out + (size_t)tok * DM) + lane; unsigned long long* o8 = (unsigned long long*)(XB + (size_t)tok * DM) + lane;
#pragma unroll
                for (int j = 0; j < 4; ++j) { const f32x4 gv = ((const f32x4*)lg)[lane + 64 * j], bv = ((const f32x4*)lb)[lane + 64 * j];
                    const f32x4 y = v[j] * rstd * gv + bv;
                    if (lastl) o4[64 * j] = y; else o8[64 * j] = (unsigned long long)pk2(y.x, y.y) | ((unsigned long long)pk2(y.z, y.w) << 32); }
            }
        }
        SEAM(pbase + PH_COMB);
    }
    PROBE_SPIN(N_PHASES - 1);
#undef IN
#undef SEAM
}

static void launch_mk(Args a, int lo, int hi, int grid, hipStream_t stream) {
    a.ph_lo = lo; a.ph_hi = hi;
    hipLaunchKernelGGL(mk, dim3(grid), dim3(NWAVES * 64), LDS_BYTES, stream, a);
}
extern "C" void kernel_launch(void* const* d_in, const int* in_sizes, int n_in, void* d_out, int out_size, void* d_ws, size_t ws_size, hipStream_t stream) {
    static int grid = 0;
    if (grid == 0) {
        if (n_in != 15 || ws_size < WS_END) { fprintf(stderr, "kernel_launch: unexpected n_in %d / ws %zu\n", n_in, ws_size); grid = -1; return; }
        if (hipFuncSetAttribute((const void*)mk, hipFuncAttributeMaxDynamicSharedMemorySize, LDS_BYTES) != hipSuccess) { fprintf(stderr, "hipFuncSetAttribute failed\n"); grid = -1; return; }
        int dev = 0, cus = 0; (void)hipGetDevice(&dev); (void)hipDeviceGetAttribute(&cus, hipDeviceAttributeMultiprocessorCount, dev);
        grid = cus > 0 ? cus : 256;
    }
    if (grid < 0) return;
    (void)hipMemsetAsync((char*)d_ws + WS_CTL, 0, CTL_ZERO_BYTES, stream);
    Args a{};
    for (int i = 0; i < 15; ++i) a.in[i] = (const float*)d_in[i];
    a.out = (float*)d_out; a.ws = (unsigned char*)d_ws;
#if ONE_LAUNCH
    launch_mk(a, 0, N_PHASES, grid, stream);
#else
    for (int p = 0; p < N_PHASES; ++p) launch_mk(a, p, p + 1, grid, stream);
#endif
}
```
